# Optimizing an MI355X kernel written in HIP

```python
import jax, jax.numpy as jnp
from jax import lax
import numpy as np

D_MODEL = 2048
BATCH = 1
SEQ = 16384
DEPTH = 1

GRID_W = 64
CTX_LEN = 256
N_HEADS_ATTN = 16
HEAD_DIM = 64
D_ATTN = N_HEADS_ATTN * HEAD_DIM
D_MIX = D_MODEL
D_CONV = D_MIX - D_ATTN
N_CONV_GROUPS = 16
CONV_WIDTH = 3
WIN_H = 8
WIN_W = 16
ROW_BLOCK = 2
D_FF = 5632
ROPE_BASE = 10000.0
EPS = 1e-6
N_MOD = 9
SPLITS = (D_ATTN, 2 * D_ATTN, 3 * D_ATTN, 3 * D_ATTN + D_CONV, 3 * D_ATTN + 2 * D_CONV)
D_IN = 3 * D_ATTN + 3 * D_CONV

kernel_name = "hybrid_na_shortconv_macaron_dit_layer"


def rmsnorm(x, g):
    xf = x.astype(jnp.float32)
    y = xf * lax.rsqrt(jnp.mean(xf * xf, axis=-1, keepdims=True) + EPS)
    return (y * g.astype(jnp.float32)).astype(x.dtype)


def modulate(h, shift, scale):
    return h * (1 + scale) + shift


def ada_mod(cvec, w_ada, b_ada):
    m = jax.nn.silu(cvec) @ w_ada + b_ada
    return jnp.split(m[..., None, :], N_MOD, axis=-1)


def half_ffn(x, mods, g_norm, w_in, w_out):
    shift, scale, gate = mods
    h = modulate(rmsnorm(x, g_norm), shift, scale)
    a, b = jnp.split(h @ w_in, 2, axis=-1)
    return x + 0.5 * gate * ((jax.nn.silu(a) * b) @ w_out)


def heads(t):
    return t.reshape(t.shape[0], t.shape[1], -1, HEAD_DIM)


def _rotate(xa, pos):
    nf = xa.shape[-1] // 2
    inv = ROPE_BASE ** (-jnp.arange(nf, dtype=jnp.float32) / nf)
    ang = pos.astype(jnp.float32)[:, None] * inv[None, :]
    cos = jnp.cos(ang)[None, :, None, :].astype(xa.dtype)
    sin = jnp.sin(ang)[None, :, None, :].astype(xa.dtype)
    x1, x2 = xa[..., :nf], xa[..., nf:]
    return jnp.concatenate([x1 * cos - x2 * sin, x1 * sin + x2 * cos], axis=-1)


def axial_rope(t, pos_r, pos_c):
    half = t.shape[-1] // 2
    return jnp.concatenate([_rotate(t[..., :half], pos_r), _rotate(t[..., half:], pos_c)], axis=-1)


def neighbourhood_attention(q, k, v, k_ctx, v_ctx, rpb, rows):
    B, S, H, Dh = q.shape
    kh = min(WIN_H, rows)
    n_blocks = rows // ROW_BLOCK
    scale = Dh ** -0.5
    qg = q.reshape(B, rows, GRID_W, H, Dh)
    kg = k.reshape(B, rows, GRID_W, H, Dh)
    vg = v.reshape(B, rows, GRID_W, H, Dh)
    cols = np.arange(GRID_W)
    col_start = np.clip(cols - WIN_W // 2, 0, GRID_W - WIN_W)
    col_idx = col_start[:, None] + np.arange(WIN_W)[None, :]
    dc = col_idx - cols[:, None] + (WIN_W - 1)

    def block(bi):
        r = bi * ROW_BLOCK + jnp.arange(ROW_BLOCK)
        rs = jnp.clip(r - kh // 2, 0, rows - kh)
        row_idx = rs[:, None] + jnp.arange(kh)[None, :]
        dr = row_idx - r[:, None] + (WIN_H - 1)
        qb = lax.dynamic_slice_in_dim(qg, bi * ROW_BLOCK, ROW_BLOCK, axis=1)
        kb = kg[:, row_idx][:, :, :, col_idx]
        vb = vg[:, row_idx][:, :, :, col_idx]
        bias = rpb[:, dr[:, None, :, None], dc[None, :, None, :]]
        bias = jnp.transpose(bias, (1, 2, 0, 3, 4))
        s_loc = jnp.einsum('brwhd,brkwjhd->brwhkj', qb, kb) * scale + bias
        s_ctx = jnp.einsum('brwhd,blhd->brwhl', qb, k_ctx) * scale
        s = jnp.concatenate([s_loc.reshape(B, ROW_BLOCK, GRID_W, H, kh * WIN_W), s_ctx], axis=-1)
        p = jax.nn.softmax(s.astype(jnp.float32), axis=-1).astype(v.dtype)
        p_loc = p[..., :kh * WIN_W].reshape(B, ROW_BLOCK, GRID_W, H, kh, WIN_W)
        p_ctx = p[..., kh * WIN_W:]
        return (jnp.einsum('brwhkj,brkwjhd->brwhd', p_loc, vb)
                + jnp.einsum('brwhl,blhd->brwhd', p_ctx, v_ctx))

    out = lax.map(block, jnp.arange(n_blocks))
    return jnp.moveaxis(out, 0, 1).reshape(B, S, H * Dh)


def context_attention(q, k, v):
    B, L, H, Dh = q.shape
    s = jnp.einsum('blhd,bmhd->bhlm', q, k) * (Dh ** -0.5)
    p = jax.nn.softmax(s.astype(jnp.float32), axis=-1).astype(v.dtype)
    return jnp.einsum('bhlm,bmhd->blhd', p, v).reshape(B, L, H * Dh)


def gated_short_conv(bg, cg, u, conv_w, conv_b):
    z = cg * u
    S = z.shape[1]
    pad = CONV_WIDTH // 2
    zp = jnp.pad(z, ((0, 0), (pad, pad), (0, 0)))
    y = conv_b
    for j in range(CONV_WIDTH):
        y = y + zp[:, j:j + S] * conv_w[j]
    return bg * y


def setup_inputs(seed: int = 0) -> dict:
    key = jax.random.key(seed)
    ks = jax.random.split(key, 24)
    f32 = jnp.float32
    L, D = DEPTH, D_MODEL

    def nrm(k, shape, s):
        return jax.random.normal(k, shape, f32) * s

    def gain(k, shape):
        return 1.0 + 0.05 * jax.random.normal(k, shape, f32)

    return {
        "x": nrm(ks[0], (BATCH, SEQ, D), 1.0),
        "c": nrm(ks[1], (BATCH, D), 1.0),
        "ctx": nrm(ks[2], (BATCH, CTX_LEN, D), 1.0),
        "c_ctx": nrm(ks[3], (D,), 1.0),
        "w_ada": nrm(ks[4], (L, D, N_MOD * D), 0.5 * D ** -0.5),
        "b_ada": nrm(ks[5], (L, N_MOD * D), 0.02),
        "ff1_norm": gain(ks[6], (L, D)),
        "ff1_w_in": nrm(ks[7], (L, D, 2 * D_FF), D ** -0.5),
        "ff1_w_out": nrm(ks[8], (L, D_FF, D), D_FF ** -0.5),
        "mix_norm": gain(ks[9], (L, D)),
        "w_in": nrm(ks[10], (L, D, D_IN), D ** -0.5),
        "q_norm": gain(ks[11], (L, HEAD_DIM)),
        "k_norm": gain(ks[12], (L, HEAD_DIM)),
        "rpb": nrm(ks[13], (L, N_HEADS_ATTN, 2 * WIN_H - 1, 2 * WIN_W - 1), 0.1),
        "conv_w": nrm(ks[14], (L, CONV_WIDTH, D_CONV), CONV_WIDTH ** -0.5),
        "conv_b": nrm(ks[15], (L, D_CONV), 0.02),
        "out_norm_attn": gain(ks[16], (L, D_ATTN)),
        "out_norm_conv": gain(ks[17], (L, D_CONV)),
        "w_out": nrm(ks[18], (L, D_MIX, D), D_MIX ** -0.5),
        "ff2_norm": gain(ks[19], (L, D)),
        "ff2_w_in": nrm(ks[20], (L, D, 2 * D_FF), D ** -0.5),
        "ff2_w_out": nrm(ks[21], (L, D_FF, D), D_FF ** -0.5),
    }


def reference(x, c, ctx, c_ctx, w_ada, b_ada, ff1_norm, ff1_w_in, ff1_w_out, mix_norm, w_in,
              q_norm, k_norm, rpb, conv_w, conv_b, out_norm_attn, out_norm_conv, w_out,
              ff2_norm, ff2_w_in, ff2_w_out):
    B, S, _ = x.shape
    rows = S // GRID_W
    pos = jnp.arange(S, dtype=jnp.int32)
    pos_r, pos_c = pos // GRID_W, pos % GRID_W

    for l in range(DEPTH):
        update_ctx = l < DEPTH - 1
        mx = ada_mod(c, w_ada[l], b_ada[l])
        mc = ada_mod(c_ctx[None], w_ada[l], b_ada[l])

        x = half_ffn(x, mx[0:3], ff1_norm[l], ff1_w_in[l], ff1_w_out[l])
        ctx = half_ffn(ctx, mc[0:3], ff1_norm[l], ff1_w_in[l], ff1_w_out[l])

        hx = modulate(rmsnorm(x, mix_norm[l]), mx[3], mx[4])
        hc = modulate(rmsnorm(ctx, mix_norm[l]), mc[3], mc[4])
        q, k, v, bg, cg, u = jnp.split(hx @ w_in[l], SPLITS, axis=-1)
        q = axial_rope(rmsnorm(heads(q), q_norm[l]), pos_r, pos_c)
        k = axial_rope(rmsnorm(heads(k), k_norm[l]), pos_r, pos_c)
        v = heads(v)
        if update_ctx:
            qc, kc, vc, bgc, cgc, uc = jnp.split(hc @ w_in[l], SPLITS, axis=-1)
        else:
            kc, vc = jnp.split(hc @ w_in[l][:, D_ATTN:3 * D_ATTN], 2, axis=-1)
        kc = rmsnorm(heads(kc), k_norm[l])
        vc = heads(vc)

        attn = neighbourhood_attention(q, k, v, kc, vc, rpb[l], rows)
        conv = gated_short_conv(bg, cg, u, conv_w[l], conv_b[l])
        y = jnp.concatenate([rmsnorm(attn, out_norm_attn[l]), rmsnorm(conv, out_norm_conv[l])],
                            axis=-1) @ w_out[l]
        if update_ctx:
            attn_c = context_attention(rmsnorm(heads(qc), q_norm[l]), kc, vc)
            conv_c = gated_short_conv(bgc, cgc, uc, conv_w[l], conv_b[l])
            yc = jnp.concatenate([rmsnorm(attn_c, out_norm_attn[l]), rmsnorm(conv_c, out_norm_conv[l])],
                                 axis=-1) @ w_out[l]
            ctx = ctx + mc[5] * yc
        x = x + mx[5] * y

        x = half_ffn(x, mx[6:9], ff2_norm[l], ff2_w_in[l], ff2_w_out[l])
        if update_ctx:
            ctx = half_ffn(ctx, mc[6:9], ff2_norm[l], ff2_w_in[l], ff2_w_out[l])
    return x
```

```cpp
#include <hip/hip_runtime.h>
#include <cstdio>
#include <cstdint>

#define LAS __attribute__((address_space(3)))
typedef unsigned short bf16_t;
typedef short bf16x8 __attribute__((ext_vector_type(8)));
typedef float f32x4 __attribute__((ext_vector_type(4)));
typedef float f32x16 __attribute__((ext_vector_type(16)));
typedef unsigned u32x4 __attribute__((ext_vector_type(4)));
typedef unsigned u32x2 __attribute__((ext_vector_type(2)));

#ifndef MK_N_LAUNCHES
#define MK_N_LAUNCHES 1
#endif

constexpr int SEQ = 16384, CTX = 256, MT = SEQ + CTX, DM = 2048, FF = 5632, FF2 = 2 * FF, DIN = 6144, DA = 1024, NH = 16;
constexpr int NMOD = 9 * DM;
constexpr float EPS = 1e-6f, LOG2E = 1.4426950408889634f;
constexpr int KSPLIT = 32;

constexpr size_t MiB = 1u << 20;
constexpr size_t WS_MODS = 0;
constexpr size_t WS_ROPE = 256 * 1024;
constexpr size_t WS_MPART = 1 * MiB;
constexpr size_t WS_SSQ = 6 * MiB;
constexpr size_t WS_WT1 = 8 * MiB, WS_WT2 = 52 * MiB, WS_WT3 = 74 * MiB, WS_WT4 = 98 * MiB, WS_WT5 = 106 * MiB, WS_WT6 = 150 * MiB;
constexpr size_t WS_H = 172 * MiB;
constexpr size_t WS_X1 = 237 * MiB;
constexpr size_t WS_G = 367 * MiB;
constexpr size_t WS_Q = 367 * MiB, WS_K = 399 * MiB, WS_VT = 432 * MiB, WS_BG = 465 * MiB, WS_Z = 497 * MiB;
constexpr size_t WS_END = 546 * MiB;

__device__ __forceinline__ unsigned cvt_pk_bf16(float lo, float hi) { unsigned r; asm("v_cvt_pk_bf16_f32 %0, %1, %2" : "=v"(r) : "v"(lo), "v"(hi)); return r; }
__device__ __forceinline__ float bf2f(unsigned short b) { return __builtin_bit_cast(float, (unsigned)b << 16); }
__device__ __forceinline__ float wave_sum(float v) {
#pragma unroll
    for (int o = 1; o < 64; o <<= 1) v += __shfl_xor(v, o);
    return v;
}
__device__ __forceinline__ float silu_f(float a) { return a * __builtin_amdgcn_rcpf(1.0f + __builtin_amdgcn_exp2f(-a * LOG2E)); }

namespace pg8 {
constexpr int BM = 256, BK = 64, HALF = 128, HTB = HALF * BK * 2, STAGE_BYTES = 8 * HTB, NXCD = 8, WGM = 8;
__host__ __device__ __forceinline__ int lds_byte(int r, int c) { const int st = (r >> 4) * 2 + (c >> 5), rr = r & 15, cc = c & 31, ob = rr * 64 + cc * 2; return st * 1024 + (ob ^ (((ob >> 9) & 1) << 5)); }
__host__ __device__ __forceinline__ void stage_rc(int b, int& R, int& C) { const int st = b / 1024, sb = b % 1024, swz = sb ^ (((sb >> 9) & 1) << 5); R = (st >> 1) * 16 + swz / 64; C = (st & 1) * 32 + (swz % 64) / 2; }
__host__ __device__ __forceinline__ int perm32(int rho) { const int n = rho >> 4, i = rho & 15; return 8 * (i >> 2) + 4 * n + (i & 3); }

struct Unit { int pm, pn, kind; const char* pa; const char* pb; };

template <class Epi, class Sched>
__device__ __forceinline__ void gemm_phase(LAS unsigned char* lds, const int K, const Sched& S, const Epi& E) {
    const int tid = threadIdx.x, wid = __builtin_amdgcn_readfirstlane(tid >> 6), lane = tid & 63, wr = wid >> 2, wc = wid & 3, fr = lane & 15, fq = lane >> 4;
    const int nt = K / BK;
    unsigned voffA[2], voffB[2];
#pragma unroll
    for (int i = 0; i < 2; ++i) { int R, C; stage_rc(tid * 16 + i * 8192, R, C); const int Rb = (R & ~31) + perm32(R & 31);
        voffA[i] = (unsigned)(R * K + C) * 2u; voffB[i] = (unsigned)(Rb * K + C) * 2u; }
    const size_t kstep = (size_t)(BK * 2);
    const size_t hstep = (size_t)HALF * K * 2;
    const unsigned ldsw = (unsigned)wid * 1024u;
    const int aoff = lds_byte(wr * 64 + fr, fq * 8), boff = lds_byte(wc * 32 + fr, fq * 8);
#define PG8_SA(b, h) (((b) * 2 + (h)) * HTB)
#define PG8_SB(b, h) ((4 + (b) * 2 + (h)) * HTB)
#define PG8_STAGE(bufoff, gbase, voff) do { _Pragma("unroll") for (int _i = 0; _i < 2; ++_i) \
        __builtin_amdgcn_global_load_lds((const unsigned*)((const char*)(gbase) + (voff)[_i]), (LAS unsigned*)(lds + (bufoff) + ldsw + _i * 8192), 16, 0, 0); } while (0)
#define PG8_LDA(dst, b, h) do { _Pragma("unroll") for (int m = 0; m < 4; ++m) _Pragma("unroll") for (int k = 0; k < 2; ++k) dst[m][k] = *(const LAS bf16x8*)(lds + PG8_SA(b, h) + aoff + m * 2048 + k * 1024); } while (0)
#define PG8_LDB(dst, b, h) do { _Pragma("unroll") for (int n = 0; n < 2; ++n) _Pragma("unroll") for (int k = 0; k < 2; ++k) dst[n][k] = *(const LAS bf16x8*)(lds + PG8_SB(b, h) + boff + n * 2048 + k * 1024); } while (0)
#define PG8_MMA(ai, bj, At, Bt) do { __builtin_amdgcn_s_setprio(1); _Pragma("unroll") for (int m = 0; m < 4; ++m) _Pragma("unroll") for (int n = 0; n < 2; ++n) _Pragma("unroll") for (int k = 0; k < 2; ++k) \
        acc[ai][bj][m][n] = __builtin_amdgcn_mfma_f32_16x16x32_bf16(Bt[n][k], At[m][k], acc[ai][bj][m][n], 0, 0, 0); __builtin_amdgcn_s_setprio(0); } while (0)
#define PG8_WAIT_V(n) asm volatile("s_waitcnt vmcnt(" #n ")" ::: "memory")
#define PG8_WAIT_L(n) asm volatile("s_waitcnt lgkmcnt(" #n ")" ::: "memory")
#define PG8_BAR __builtin_amdgcn_s_barrier()
#define PG8_SCHED __builtin_amdgcn_sched_barrier(0)
    Unit cur, nxt; int ui = 0;
    if (!S.next(0, cur)) return;
    f32x4 acc[2][2][4][2];
#pragma unroll
    for (int a = 0; a < 2; ++a)
#pragma unroll
        for (int b = 0; b < 2; ++b)
#pragma unroll
            for (int m = 0; m < 4; ++m)
#pragma unroll
                for (int n = 0; n < 2; ++n) acc[a][b][m][n] = (f32x4){0.f, 0.f, 0.f, 0.f};
    bf16x8 At[4][2], B0[2][2], B1[2][2];
    const char* cA = cur.pa; const char* cB = cur.pb;
    PG8_STAGE(PG8_SB(0, 0), cB, voffB); PG8_STAGE(PG8_SB(0, 1), cB + hstep, voffB); PG8_STAGE(PG8_SA(0, 0), cA, voffA); PG8_STAGE(PG8_SA(0, 1), cA + hstep, voffA);
    if (wr == 1) PG8_BAR;
    PG8_WAIT_V(2); PG8_BAR;
    PG8_STAGE(PG8_SB(1, 0), cB + kstep, voffB); PG8_STAGE(PG8_SA(1, 0), cA + kstep, voffA); PG8_STAGE(PG8_SB(1, 1), cB + hstep + kstep, voffB);
    PG8_WAIT_V(6); PG8_BAR;
    for (;;) {
        const bool has_next = S.next(ui + 1, nxt);
        const char* nA = has_next ? nxt.pa : cA; const char* nB = has_next ? nxt.pb : cB;
        for (int t = 0; t < nt; t += 2) {
            const bool last = (t == nt - 2);
            const char* a1 = cA + (size_t)(t + 1) * kstep;
            const char* a2 = last ? nA : cA + (size_t)(t + 2) * kstep; const char* b2 = last ? nB : cB + (size_t)(t + 2) * kstep;
            const char* a3 = a2 + kstep; const char* b3 = b2 + kstep;
            PG8_LDB(B0, 0, 0); PG8_LDB(B1, 0, 1); PG8_SCHED; PG8_LDA(At, 0, 0); PG8_STAGE(PG8_SA(1, 1), a1 + hstep, voffA);
            PG8_WAIT_V(8); PG8_WAIT_L(0); PG8_BAR; PG8_MMA(0, 0, At, B0); PG8_MMA(0, 1, At, B1); PG8_BAR; PG8_SCHED;
            PG8_LDA(At, 0, 1); PG8_STAGE(PG8_SB(0, 0), b2, voffB); PG8_STAGE(PG8_SB(0, 1), b2 + hstep, voffB); PG8_STAGE(PG8_SA(0, 0), a2, voffA);
            PG8_WAIT_V(8); PG8_WAIT_L(0); PG8_BAR; PG8_MMA(1, 0, At, B0); PG8_MMA(1, 1, At, B1); PG8_BAR; PG8_SCHED;
            PG8_LDB(B0, 1, 0); PG8_LDB(B1, 1, 1); PG8_SCHED; PG8_LDA(At, 1, 0); PG8_STAGE(PG8_SA(0, 1), a2 + hstep, voffA);
            PG8_WAIT_V(8); PG8_WAIT_L(0); PG8_BAR; PG8_MMA(0, 0, At, B0); PG8_MMA(0, 1, At, B1); PG8_BAR; PG8_SCHED;
            PG8_LDA(At, 1, 1); PG8_STAGE(PG8_SB(1, 0), b3, voffB); PG8_STAGE(PG8_SB(1, 1), b3 + hstep, voffB); PG8_STAGE(PG8_SA(1, 0), a3, voffA);
            PG8_WAIT_V(8); PG8_WAIT_L(0); PG8_BAR; PG8_MMA(1, 0, At, B0); PG8_MMA(1, 1, At, B1); PG8_BAR; PG8_SCHED;
        }
        if (wr == 0) PG8_BAR;
        E(acc, cur, wr, wc, fr, fq);
        if (!has_next) break;
#pragma unroll
        for (int a = 0; a < 2; ++a)
#pragma unroll
            for (int b = 0; b < 2; ++b)
#pragma unroll
                for (int m = 0; m < 4; ++m)
#pragma unroll
                    for (int n = 0; n < 2; ++n) acc[a][b][m][n] = (f32x4){0.f, 0.f, 0.f, 0.f};
        cur = nxt; cA = nA; cB = nB; ++ui;
        if (wr == 1) PG8_BAR;
    }
    PG8_WAIT_V(0);
    PG8_BAR;
#undef PG8_SA
#undef PG8_SB
#undef PG8_STAGE
#undef PG8_LDA
#undef PG8_LDB
#undef PG8_MMA
#undef PG8_WAIT_V
#undef PG8_WAIT_L
#undef PG8_BAR
#undef PG8_SCHED
}
}

enum { KQ = 0, KK = 1, KKCTX = 2, KBG = 3, KZ = 4, KVT = 5 };
struct GSched {
    const char* A; const char* B; int K, nM, nN, nX, mode, G, c;
    __device__ __forceinline__ bool next(int i, pg8::Unit& u) const {
        const int nwg = nM * nN; const long L = (long)i * G + c; if (L >= nwg + nX) return false;
        const size_t tstep = (size_t)256 * K * 2;
        if (L < nwg) {
            int wgid = (int)L; { const int q = nwg / pg8::NXCD, r = nwg % pg8::NXCD, xcd = wgid % pg8::NXCD, off = wgid / pg8::NXCD; wgid = (xcd < r ? xcd * (q + 1) : r * (q + 1) + (xcd - r) * q) + off; }
            const int nig = pg8::WGM * nN, gid = wgid / nig, fm = gid * pg8::WGM, gsz = (nM - fm) < pg8::WGM ? (nM - fm) : pg8::WGM;
            const int pm = fm + ((wgid % nig) % gsz), pi = (wgid % nig) / gsz;
            int pnB = pi, kind = 0;
            if (mode == 3) { pnB = pi < 8 ? pi : pi + 4; kind = pi < 4 ? KQ : pi < 8 ? KK : pi < 12 ? KBG : KZ; }
            u.pm = pm; u.pn = pnB; u.kind = kind; u.pa = A + (size_t)pm * tstep; u.pb = B + (size_t)pnB * tstep;
        } else {
            const int x = (int)(L - nwg);
            if (mode != 3) { u.pm = nM; u.pn = x; u.kind = 0; u.pa = A + (size_t)nM * tstep; u.pb = B + (size_t)x * tstep; }
            else if (x < 4) { u.pm = 64; u.pn = 4 + x; u.kind = KKCTX; u.pa = A + (size_t)64 * tstep; u.pb = B + (size_t)(4 + x) * tstep; }
            else { const int v = x - 4, pmv = v / 65, pnv = v % 65; u.pm = pmv; u.pn = pnv; u.kind = KVT; u.pa = B + (size_t)(8 + pmv) * tstep; u.pb = A + (size_t)pnv * tstep; }
        }
        return true;
    }
};

typedef f32x4 Acc[2][2][4][2];
struct EpiSwiGLU {
    bf16_t* G;
    __device__ __forceinline__ void operator()(const Acc& acc, const pg8::Unit& u, int wr, int wc, int fr, int fq) const {
        const int row0 = u.pm * 256 + wr * 64 + fr, col0 = u.pn * 128 + wc * 32 + 8 * fq;
#pragma unroll
        for (int ai = 0; ai < 2; ++ai)
#pragma unroll
            for (int m = 0; m < 4; ++m) {
                bf16_t* p = G + (size_t)(row0 + ai * 128 + m * 16) * FF + col0;
                const f32x4 a0 = acc[ai][0][m][0], a1 = acc[ai][0][m][1], b0 = acc[ai][1][m][0], b1 = acc[ai][1][m][1];
                u32x4 w;
                w.x = cvt_pk_bf16(silu_f(a0[0]) * b0[0], silu_f(a0[1]) * b0[1]); w.y = cvt_pk_bf16(silu_f(a0[2]) * b0[2], silu_f(a0[3]) * b0[3]);
                w.z = cvt_pk_bf16(silu_f(a1[0]) * b1[0], silu_f(a1[1]) * b1[1]); w.w = cvt_pk_bf16(silu_f(a1[2]) * b1[2], silu_f(a1[3]) * b1[3]);
                *(u32x4*)p = w;
            }
    }
};
struct EpiResid {
    const float* base_x; const float* base_c; float* out; const float* gate_x; const float* gate_c; float s;
    __device__ __forceinline__ void operator()(const Acc& acc, const pg8::Unit& u, int wr, int wc, int fr, int fq) const {
        const bool isc = u.pm >= 64;
        const float* base = isc ? base_c - (size_t)SEQ * DM : base_x; const float* gate = isc ? gate_c : gate_x;
        const int row0 = u.pm * 256 + wr * 64 + fr, col0 = u.pn * 256 + wc * 32 + 8 * fq;
        f32x4 gv[2][2];
#pragma unroll
        for (int bj = 0; bj < 2; ++bj)
#pragma unroll
            for (int n = 0; n < 2; ++n) gv[bj][n] = *(const f32x4*)(gate + col0 + bj * 128 + 4 * n) * s;
#pragma unroll
        for (int ai = 0; ai < 2; ++ai)
#pragma unroll
            for (int m = 0; m < 4; ++m) {
                const size_t off = (size_t)(row0 + ai * 128 + m * 16) * DM + col0;
#pragma unroll
                for (int bj = 0; bj < 2; ++bj)
#pragma unroll
                    for (int n = 0; n < 2; ++n) {
                        const f32x4 b = *(const f32x4*)(base + off + bj * 128 + 4 * n);
                        *(f32x4*)(out + off + bj * 128 + 4 * n) = b + gv[bj][n] * acc[ai][bj][m][n];
                    }
            }
    }
};
struct EpiInProj {
    bf16_t *Q, *Kb, *Vt, *BG, *Z; const float *qn, *kn, *rc, *rs;
    template <bool ROPE> __device__ __forceinline__ void qk(const Acc& acc, int row0, bf16_t* dst, int head, const float* gain, float oscale, int fq) const {
        f32x4 g[2][2];
#pragma unroll
        for (int bj = 0; bj < 2; ++bj)
#pragma unroll
            for (int n = 0; n < 2; ++n) g[bj][n] = *(const f32x4*)(gain + 32 * bj + 16 * n + 4 * fq);
#pragma unroll
        for (int ai = 0; ai < 2; ++ai)
#pragma unroll
            for (int m = 0; m < 4; ++m) {
                const int r = row0 + ai * 128 + m * 16;
                float ss = 0.f;
#pragma unroll
                for (int bj = 0; bj < 2; ++bj)
#pragma unroll
                    for (int n = 0; n < 2; ++n) { const f32x4 v = acc[ai][bj][m][n]; ss += (v[0] * v[0] + v[1] * v[1]) + (v[2] * v[2] + v[3] * v[3]); }
                ss += __shfl_xor(ss, 16); ss += __shfl_xor(ss, 32);
                const float rinv = __builtin_amdgcn_rsqf(ss * (1.0f / 64.0f) + EPS) * oscale;
                bf16_t* p = dst + (size_t)r * DA + head * 64 + 4 * fq;
#pragma unroll
                for (int bj = 0; bj < 2; ++bj) {
                    const f32x4 y0 = acc[ai][bj][m][0] * rinv * g[bj][0], y1 = acc[ai][bj][m][1] * rinv * g[bj][1];
                    f32x4 o1, o2;
                    if (ROPE) { const int pos = bj ? (r & 63) : (r >> 6);
                        const f32x4 C = *(const f32x4*)(rc + pos * 16 + 4 * fq), Sn = *(const f32x4*)(rs + pos * 16 + 4 * fq);
                        o1 = y0 * C - y1 * Sn; o2 = y0 * Sn + y1 * C; }
                    else { o1 = y0; o2 = y1; }
                    u32x2 w1, w2; w1.x = cvt_pk_bf16(o1[0], o1[1]); w1.y = cvt_pk_bf16(o1[2], o1[3]); w2.x = cvt_pk_bf16(o2[0], o2[1]); w2.y = cvt_pk_bf16(o2[2], o2[3]);
                    *(u32x2*)(p + 32 * bj) = w1; *(u32x2*)(p + 32 * bj + 16) = w2;
                }
            }
    }
    __device__ __forceinline__ void operator()(const Acc& acc, const pg8::Unit& u, int wr, int wc, int fr, int fq) const {
        const int row0 = u.pm * 256 + wr * 64 + fr;
        if (u.kind == KQ) { qk<true>(acc, row0, Q, 4 * u.pn + wc, qn, 0.125f * LOG2E, fq); }
        else if (u.kind == KK) { qk<true>(acc, row0, Kb, 4 * (u.pn - 4) + wc, kn, 1.0f, fq); }
        else if (u.kind == KKCTX) { qk<false>(acc, row0, Kb, 4 * (u.pn - 4) + wc, kn, 1.0f, fq); }
        else if (u.kind == KZ) {
            const int col0 = (u.pn - 16) * 128 + wc * 32 + 8 * fq;
#pragma unroll
            for (int ai = 0; ai < 2; ++ai)
#pragma unroll
                for (int m = 0; m < 4; ++m) {
                    const f32x4 z0 = acc[ai][0][m][0] * acc[ai][1][m][0], z1 = acc[ai][0][m][1] * acc[ai][1][m][1];
                    u32x4 w; w.x = cvt_pk_bf16(z0[0], z0[1]); w.y = cvt_pk_bf16(z0[2], z0[3]); w.z = cvt_pk_bf16(z1[0], z1[1]); w.w = cvt_pk_bf16(z1[2], z1[3]);
                    *(u32x4*)(Z + (size_t)(row0 + ai * 128 + m * 16) * DA + col0) = w;
                }
        } else {
            bf16_t* dst; size_t ld; int col0;
            if (u.kind == KBG) { dst = BG; ld = DA; col0 = (u.pn - 12) * 256 + wc * 32 + 8 * fq; }
            else { dst = Vt; ld = MT; col0 = u.pn * 256 + wc * 32 + 8 * fq; }
#pragma unroll
            for (int ai = 0; ai < 2; ++ai)
#pragma unroll
                for (int m = 0; m < 4; ++m)
#pragma unroll
                    for (int bj = 0; bj < 2; ++bj) {
                        const f32x4 v0 = acc[ai][bj][m][0], v1 = acc[ai][bj][m][1];
                        u32x4 w; w.x = cvt_pk_bf16(v0[0], v0[1]); w.y = cvt_pk_bf16(v0[2], v0[3]); w.z = cvt_pk_bf16(v1[0], v1[1]); w.w = cvt_pk_bf16(v1[2], v1[3]);
                        *(u32x4*)(dst + (size_t)(row0 + ai * 128 + m * 16) * ld + col0 + bj * 128) = w;
                    }
        }
    }
};

__device__ __forceinline__ int colmap(int mode, int np) {
    if (mode == 1) { const int tile = np >> 8, w = np & 255; return (w >> 7) * FF + tile * 128 + (w & 127); }
    if (mode == 3) {
        if (np < 2048) { const int base = np & ~1023, rel = np & 1023, tile = rel >> 8, w = rel & 255;
            const int bj = w >> 7, wc = (w >> 5) & 3, fq = (w >> 3) & 3, n = (w >> 2) & 1, e = w & 3;
            return base + 64 * (4 * tile + wc) + 32 * bj + 16 * n + 4 * fq + e; }
        if (np < 4096) return np;
        const int rel = np - 4096, tile = rel >> 8, w = rel & 255; return ((w >> 7) ? 5120 : 4096) + tile * 128 + (w & 127);
    }
    return np;
}
__device__ __forceinline__ void transpose_item(const float* W, int K, int N, bf16_t* Wt, int mode, int item, int lane) {
    const int nblk = N / 32, kb = item / nblk, nb = item % nblk;
    const int ns = lane & 7, kg = lane >> 3, np0 = nb * 32 + 4 * ns, c0 = colmap(mode, np0), k0 = kb * 64 + 8 * kg;
    f32x4 v[8];
#pragma unroll
    for (int j = 0; j < 8; ++j) v[j] = *(const f32x4*)(W + (size_t)(k0 + j) * N + c0);
#pragma unroll
    for (int e = 0; e < 4; ++e) { u32x4 w; w.x = cvt_pk_bf16(v[0][e], v[1][e]); w.y = cvt_pk_bf16(v[2][e], v[3][e]); w.z = cvt_pk_bf16(v[4][e], v[5][e]); w.w = cvt_pk_bf16(v[6][e], v[7][e]);
        *(u32x4*)(Wt + (size_t)(np0 + e) * K + k0) = w; }
}
__device__ __forceinline__ void ada_item(const float* wada, const float* cvec, const float* cctx, float* part, int item, int lane) {
    const int ks = item / 72, cc = item % 72;
    const float sx = silu_f(cvec[ks * 64 + lane]), sc = silu_f(cctx[ks * 64 + lane]);
    f32x4 ax = {0.f, 0.f, 0.f, 0.f}, ac = {0.f, 0.f, 0.f, 0.f};
    const float* wp = wada + (size_t)(ks * 64) * NMOD + cc * 256 + 4 * lane;
#pragma unroll 16
    for (int k = 0; k < 64; ++k) { const f32x4 w = *(const f32x4*)(wp + (size_t)k * NMOD);
        const float a = __builtin_bit_cast(float, __builtin_amdgcn_readlane(__builtin_bit_cast(int, sx), k)), b = __builtin_bit_cast(float, __builtin_amdgcn_readlane(__builtin_bit_cast(int, sc), k));
        ax += w * a; ac += w * b; }
    *(f32x4*)(part + (size_t)(ks * 2 + 0) * NMOD + cc * 256 + 4 * lane) = ax;
    *(f32x4*)(part + (size_t)(ks * 2 + 1) * NMOD + cc * 256 + 4 * lane) = ac;
}
__device__ __forceinline__ void norm_rows(const float* src_x, const float* src_c, int nrows, bf16_t* H, const float* g, const float* mods, int ishift, int iscale, int gw, int ngw, int lane) {
    for (int m = gw; m < nrows; m += ngw) {
        const bool isc = m >= SEQ;
        const float* src = isc ? src_c + (size_t)(m - SEQ) * DM : src_x + (size_t)m * DM; const float* md = mods + (isc ? NMOD : 0);
        f32x4 v[8]; float ss = 0.f;
#pragma unroll
        for (int j = 0; j < 8; ++j) { v[j] = *(const f32x4*)(src + 4 * lane + 256 * j); ss += (v[j][0] * v[j][0] + v[j][1] * v[j][1]) + (v[j][2] * v[j][2] + v[j][3] * v[j][3]); }
        const float rinv = __builtin_amdgcn_rsqf(wave_sum(ss) * (1.0f / DM) + EPS);
#pragma unroll
        for (int j = 0; j < 8; ++j) { const int c = 4 * lane + 256 * j;
            const f32x4 gg = *(const f32x4*)(g + c), sc = *(const f32x4*)(md + iscale * DM + c), sh = *(const f32x4*)(md + ishift * DM + c);
            const f32x4 h = v[j] * rinv * gg * (sc + 1.0f) + sh;
            u32x2 w; w.x = cvt_pk_bf16(h[0], h[1]); w.y = cvt_pk_bf16(h[2], h[3]);
            *(u32x2*)(H + (size_t)m * DM + c) = w; }
    }
}

__device__ __forceinline__ void attn_unit(int u, const bf16_t* Q, const bf16_t* Kb, const bf16_t* Vt, const float* rpb, bf16_t* Y, float* ssq, LAS float* tab, int lane) {
    const int h = u >> 9, tile = u & 511, rp = tile >> 2, cg = tile & 3;
    const int ql = lane & 31, hi = lane >> 5;
    const int r0 = 2 * rp, qr = r0 + (ql >> 4), qc = 16 * cg + (ql & 15), qtok = qr * 64 + qc;
    for (int i = lane; i < 465; i += 64) tab[64 + i] = rpb[h * 465 + i] * LOG2E;
    bf16x8 qf[4];
#pragma unroll
    for (int c = 0; c < 4; ++c) qf[c] = *(const bf16x8*)(Q + (size_t)qtok * DA + h * 64 + 16 * c + 8 * hi);
    const int rs_q = min(max(qr - 4, 0), 248), cs_q = min(max(qc - 8, 0), 48);
    const int rs0 = min(max(r0 - 4, 0), 248), rs1 = min(max(r0 - 3, 0), 248);
    const int nblk = 8 + ((rs1 != rs0) ? 9 : 8);
    const int kc0 = min(max(16 * cg - 8, 0), 32);
    const int kap = (ql & 19) | ((ql & 4) << 1) | ((ql & 8) >> 1);
    const bf16_t* kbase = Kb + (size_t)kap * DA + h * 64 + 8 * hi;
    const bf16_t* vbase = Vt + (size_t)(h * 64 + ql) * MT + 8 * hi;
    f32x16 o0, o1;
#pragma unroll
    for (int i = 0; i < 16; ++i) { o0[i] = 0.f; o1[i] = 0.f; }
    float mrun = -1e30f, lrun = 0.f;
    asm volatile("s_waitcnt lgkmcnt(0)" ::: "memory");
    bf16x8 kf[4], vf[4], kn[4], vn[4];
    { const int tok0 = SEQ;
#pragma unroll
      for (int c = 0; c < 4; ++c) kn[c] = *(const bf16x8*)(kbase + (size_t)tok0 * DA + 16 * c);
#pragma unroll
      for (int d = 0; d < 2; ++d)
#pragma unroll
          for (int t = 0; t < 2; ++t) vn[d * 2 + t] = *(const bf16x8*)(vbase + (size_t)(32 * d) * MT + tok0 + 16 * t); }
    for (int b = 0; b < nblk; ++b) {
#pragma unroll
        for (int c = 0; c < 4; ++c) { kf[c] = kn[c]; vf[c] = vn[c]; }
        if (b + 1 < nblk) { const int bn = b + 1; const int tok0 = bn < 8 ? SEQ + 32 * bn : (rs0 + bn - 8) * 64 + kc0;
#pragma unroll
            for (int c = 0; c < 4; ++c) kn[c] = *(const bf16x8*)(kbase + (size_t)tok0 * DA + 16 * c);
#pragma unroll
            for (int d = 0; d < 2; ++d)
#pragma unroll
                for (int t = 0; t < 2; ++t) vn[d * 2 + t] = *(const bf16x8*)(vbase + (size_t)(32 * d) * MT + tok0 + 16 * t); }
        f32x16 s;
#pragma unroll
        for (int i = 0; i < 16; ++i) s[i] = 0.f;
#pragma unroll
        for (int c = 0; c < 4; ++c) s = __builtin_amdgcn_mfma_f32_32x32x16_bf16(kf[c], qf[c], s, 0, 0, 0);
        if (b >= 8) {
            const int kr = rs0 + b - 8;
            const bool row_ok = (kr >= rs_q) && (kr < rs_q + 8);
            const int lo = cs_q - kc0 - 8 * hi;
            const int bi = 64 + (kr - qr + 7) * 31 + (kc0 + 8 * hi - qc + 15);
#pragma unroll
            for (int i = 0; i < 16; ++i) { const int j = 16 * (i >> 3) + 4 * ((i >> 2) & 1) + (i & 3);
                const bool ok = row_ok && (j >= lo) && (j < lo + 16);
                const float bias = tab[bi + j];
                s[i] = ok ? s[i] + bias : -1e30f; }
        }
        float bm = s[0];
#pragma unroll
        for (int i = 1; i < 16; ++i) bm = fmaxf(bm, s[i]);
        bm = fmaxf(bm, __shfl_xor(bm, 32));
        const float mnew = fmaxf(mrun, bm), alpha = __builtin_amdgcn_exp2f(mrun - mnew);
        mrun = mnew;
        float ps = 0.f;
#pragma unroll
        for (int i = 0; i < 16; ++i) { s[i] = __builtin_amdgcn_exp2f(s[i] - mnew); ps += s[i]; }
        lrun = lrun * alpha + ps;
#pragma unroll
        for (int i = 0; i < 16; ++i) { o0[i] *= alpha; o1[i] *= alpha; }
        u32x4 p0, p1;
        p0.x = cvt_pk_bf16(s[0], s[1]); p0.y = cvt_pk_bf16(s[2], s[3]); p0.z = cvt_pk_bf16(s[4], s[5]); p0.w = cvt_pk_bf16(s[6], s[7]);
        p1.x = cvt_pk_bf16(s[8], s[9]); p1.y = cvt_pk_bf16(s[10], s[11]); p1.z = cvt_pk_bf16(s[12], s[13]); p1.w = cvt_pk_bf16(s[14], s[15]);
        const bf16x8 pb0 = __builtin_bit_cast(bf16x8, p0), pb1 = __builtin_bit_cast(bf16x8, p1);
        o0 = __builtin_amdgcn_mfma_f32_32x32x16_bf16(vf[0], pb0, o0, 0, 0, 0);
        o0 = __builtin_amdgcn_mfma_f32_32x32x16_bf16(vf[1], pb1, o0, 0, 0, 0);
        o1 = __builtin_amdgcn_mfma_f32_32x32x16_bf16(vf[2], pb0, o1, 0, 0, 0);
        o1 = __builtin_amdgcn_mfma_f32_32x32x16_bf16(vf[3], pb1, o1, 0, 0, 0);
    }
    const float ltot = lrun + __shfl_xor(lrun, 32), inv = 1.0f / ltot;
    float sq = 0.f;
    bf16_t* yp = Y + (size_t)qtok * DM + h * 64 + 4 * hi;
#pragma unroll
    for (int a = 0; a < 4; ++a) {
        const float x0 = o0[4 * a] * inv, x1 = o0[4 * a + 1] * inv, x2 = o0[4 * a + 2] * inv, x3 = o0[4 * a + 3] * inv;
        const float y0 = o1[4 * a] * inv, y1 = o1[4 * a + 1] * inv, y2 = o1[4 * a + 2] * inv, y3 = o1[4 * a + 3] * inv;
        sq += (x0 * x0 + x1 * x1) + (x2 * x2 + x3 * x3) + (y0 * y0 + y1 * y1) + (y2 * y2 + y3 * y3);
        u32x2 w0, w1; w0.x = cvt_pk_bf16(x0, x1); w0.y = cvt_pk_bf16(x2, x3); w1.x = cvt_pk_bf16(y0, y1); w1.y = cvt_pk_bf16(y2, y3);
        *(u32x2*)(yp + 8 * a) = w0; *(u32x2*)(yp + 32 + 8 * a) = w1;
    }
    sq += __shfl_xor(sq, 32);
    if (hi == 0) ssq[h * SEQ + qtok] = sq;
}

__device__ __forceinline__ void conv_rows(const bf16_t* BG, const bf16_t* Z, const float* cw, const float* cb, const float* gc, bf16_t* Y, int gw, int ngw, int lane) {
    for (int t = gw; t < SEQ; t += ngw) {
        float val[16]; float ss = 0.f;
#pragma unroll
        for (int hf = 0; hf < 2; ++hf) {
            const int ch = 512 * hf + 8 * lane;
            const bf16x8 bg = *(const bf16x8*)(BG + (size_t)t * DA + ch), z1 = *(const bf16x8*)(Z + (size_t)t * DA + ch);
            bf16x8 z0 = {0, 0, 0, 0, 0, 0, 0, 0}, z2 = {0, 0, 0, 0, 0, 0, 0, 0};
            if (t > 0) z0 = *(const bf16x8*)(Z + (size_t)(t - 1) * DA + ch);
            if (t < SEQ - 1) z2 = *(const bf16x8*)(Z + (size_t)(t + 1) * DA + ch);
#pragma unroll
            for (int q4 = 0; q4 < 2; ++q4) {
                const f32x4 w0 = *(const f32x4*)(cw + ch + 4 * q4), w1 = *(const f32x4*)(cw + DA + ch + 4 * q4), w2 = *(const f32x4*)(cw + 2 * DA + ch + 4 * q4), bb = *(const f32x4*)(cb + ch + 4 * q4);
#pragma unroll
                for (int e = 0; e < 4; ++e) { const int i = 4 * q4 + e;
                    const float y = bb[e] + w0[e] * bf2f((unsigned short)z0[i]) + w1[e] * bf2f((unsigned short)z1[i]) + w2[e] * bf2f((unsigned short)z2[i]);
                    const float cv = bf2f((unsigned short)bg[i]) * y; val[8 * hf + i] = cv; ss += cv * cv; }
            }
        }
        const float rinv = __builtin_amdgcn_rsqf(wave_sum(ss) * (1.0f / DA) + EPS);
#pragma unroll
        for (int hf = 0; hf < 2; ++hf) {
            const int ch = 512 * hf + 8 * lane;
            const f32x4 g0 = *(const f32x4*)(gc + ch), g1 = *(const f32x4*)(gc + ch + 4);
            u32x4 w; w.x = cvt_pk_bf16(val[8 * hf + 0] * rinv * g0[0], val[8 * hf + 1] * rinv * g0[1]); w.y = cvt_pk_bf16(val[8 * hf + 2] * rinv * g0[2], val[8 * hf + 3] * rinv * g0[3]);
            w.z = cvt_pk_bf16(val[8 * hf + 4] * rinv * g1[0], val[8 * hf + 5] * rinv * g1[1]); w.w = cvt_pk_bf16(val[8 * hf + 6] * rinv * g1[2], val[8 * hf + 7] * rinv * g1[3]);
            *(u32x4*)(Y + (size_t)t * DM + DA + ch) = w;
        }
    }
}
__device__ __forceinline__ void ynorm_rows(bf16_t* Y, const float* ssq, const float* ga, int gw, int ngw, int lane) {
    for (int t = gw; t < SEQ; t += ngw) {
        const float part = lane < NH ? ssq[lane * SEQ + t] : 0.f;
        const float rinv = __builtin_amdgcn_rsqf(wave_sum(part) * (1.0f / DA) + EPS);
#pragma unroll
        for (int hf = 0; hf < 2; ++hf) {
            const int ch = 512 * hf + 8 * lane;
            const bf16x8 a = *(const bf16x8*)(Y + (size_t)t * DM + ch);
            const f32x4 g0 = *(const f32x4*)(ga + ch), g1 = *(const f32x4*)(ga + ch + 4);
            u32x4 w; w.x = cvt_pk_bf16(bf2f((unsigned short)a[0]) * rinv * g0[0], bf2f((unsigned short)a[1]) * rinv * g0[1]); w.y = cvt_pk_bf16(bf2f((unsigned short)a[2]) * rinv * g0[2], bf2f((unsigned short)a[3]) * rinv * g0[3]);
            w.z = cvt_pk_bf16(bf2f((unsigned short)a[4]) * rinv * g1[0], bf2f((unsigned short)a[5]) * rinv * g1[1]); w.w = cvt_pk_bf16(bf2f((unsigned short)a[6]) * rinv * g1[2], bf2f((unsigned short)a[7]) * rinv * g1[3]);
            *(u32x4*)(Y + (size_t)t * DM + ch) = w;
        }
    }
}

constexpr int NPHASE = 13;
constexpr int LDS_BYTES = 147456;
struct Args { const float* in[22]; float* out; unsigned char* ws; int ph_lo, ph_hi; };

__global__ void __launch_bounds__(512, 2) fwd(Args a) {
    extern __shared__ __attribute__((aligned(16))) unsigned char lds_raw[];
    LAS unsigned char* lds = (LAS unsigned char*)lds_raw;
    const int tid = threadIdx.x, lane = tid & 63, wave = __builtin_amdgcn_readfirstlane(tid >> 6);
    const int G = gridDim.x, bx = blockIdx.x;
    const int vcu = (G % 8 == 0) ? (bx % 8) * (G / 8) + bx / 8 : bx;
    const int gw = vcu * 8 + wave, ngw = G * 8;
    unsigned char* ws = a.ws;
    const float *x = a.in[0], *cvec = a.in[1], *ctx = a.in[2], *cctx = a.in[3], *wada = a.in[4], *bada = a.in[5], *ff1n = a.in[6], *ff1wi = a.in[7], *ff1wo = a.in[8],
                *mixn = a.in[9], *win = a.in[10], *qn = a.in[11], *kn = a.in[12], *rpb = a.in[13], *convw = a.in[14], *convb = a.in[15], *ona = a.in[16], *onc = a.in[17],
                *wout = a.in[18], *ff2n = a.in[19], *ff2wi = a.in[20], *ff2wo = a.in[21];
    float* mods = (float*)(ws + WS_MODS); float* ropec = (float*)(ws + WS_ROPE); float* ropes = ropec + 256 * 16; float* mpart = (float*)(ws + WS_MPART); float* ssq = (float*)(ws + WS_SSQ);
    bf16_t *Wt1 = (bf16_t*)(ws + WS_WT1), *Wt2 = (bf16_t*)(ws + WS_WT2), *Wt3 = (bf16_t*)(ws + WS_WT3), *Wt4 = (bf16_t*)(ws + WS_WT4), *Wt5 = (bf16_t*)(ws + WS_WT5), *Wt6 = (bf16_t*)(ws + WS_WT6);
    bf16_t *H = (bf16_t*)(ws + WS_H), *Gb = (bf16_t*)(ws + WS_G), *Qb = (bf16_t*)(ws + WS_Q), *Kb = (bf16_t*)(ws + WS_K), *Vt = (bf16_t*)(ws + WS_VT), *BG = (bf16_t*)(ws + WS_BG), *Zb = (bf16_t*)(ws + WS_Z);
    float* X1 = (float*)(ws + WS_X1);
    const int lo = a.ph_lo, hi = a.ph_hi;
#define IN(k) (lo <= (k) && (k) < hi)
#define SEAM(k) do { if (IN(k) && IN((k) + 1)) __ockl_grid_sync(); } while (0)

    if (IN(0)) {
        constexpr int I_ADA = KSPLIT * 72, I_1 = (DM / 64) * (FF2 / 32), I_2 = (FF / 64) * (DM / 32), I_3 = (DM / 64) * (DIN / 32), I_4 = (DM / 64) * (DM / 32);
        constexpr int NIT = I_ADA + 2 * (I_1 + I_2) + I_3 + I_4;
        for (int it = gw; it < NIT; it += ngw) {
            int r = it;
            if (r < I_ADA) { ada_item(wada, cvec, cctx, mpart, r, lane); continue; } r -= I_ADA;
            if (r < I_1) { transpose_item(ff1wi, DM, FF2, Wt1, 1, r, lane); continue; } r -= I_1;
            if (r < I_2) { transpose_item(ff1wo, FF, DM, Wt2, 0, r, lane); continue; } r -= I_2;
            if (r < I_3) { transpose_item(win, DM, DIN, Wt3, 3, r, lane); continue; } r -= I_3;
            if (r < I_4) { transpose_item(wout, DM, DM, Wt4, 0, r, lane); continue; } r -= I_4;
            if (r < I_1) { transpose_item(ff2wi, DM, FF2, Wt5, 1, r, lane); continue; } r -= I_1;
            transpose_item(ff2wo, FF, DM, Wt6, 0, r, lane);
        }
    }
    SEAM(0);
    if (IN(1)) {
        const int gt = bx * 512 + tid;
        if (gt < 2 * NMOD / 4) { const int v = gt / (NMOD / 4), j = (gt % (NMOD / 4)) * 4;
            f32x4 s = *(const f32x4*)(bada + j);
            for (int ks = 0; ks < KSPLIT; ++ks) s += *(const f32x4*)(mpart + (size_t)(ks * 2 + v) * NMOD + j);
            *(f32x4*)(mods + v * NMOD + j) = s; }
        else if (gt < 2 * NMOD / 4 + 4096) { const int idx = gt - 2 * NMOD / 4, pos = idx >> 4, i = idx & 15;
            const int i3 = i & 3; const float base4 = i3 == 0 ? 1.0f : i3 == 1 ? 0.5623413251903491f : i3 == 2 ? 0.31622776601683794f : 0.1778279410038923f;
            const int i2 = i >> 2; const float dec = i2 == 0 ? 1.0f : i2 == 1 ? 0.1f : i2 == 2 ? 0.01f : 0.001f;
            const float inv = base4 * dec;
            const float angf = (float)pos * inv;
            const double ang = (double)angf;
            const double r = ang - 6.283185307179586 * __builtin_rint(ang * 0.15915494309189535);
            const double r2 = r * r; double sn = r, cs = 1.0, ts = r, tc = 1.0;
#pragma unroll
            for (int k = 1; k <= 12; ++k) { tc = -tc * r2 / (double)((2 * k - 1) * (2 * k)); cs += tc; ts = -ts * r2 / (double)((2 * k) * (2 * k + 1)); sn += ts; }
            ropec[idx] = (float)cs; ropes[idx] = (float)sn; }
    }
    SEAM(1);
    if (IN(2)) norm_rows(x, ctx, MT, H, ff1n, mods, 0, 1, gw, ngw, lane);
    SEAM(2);
    if (IN(3)) { GSched S{(const char*)H, (const char*)Wt1, DM, 64, 44, 44, 0, G, bx}; EpiSwiGLU E{Gb}; pg8::gemm_phase(lds, DM, S, E); }
    SEAM(3);
    if (IN(4)) { GSched S{(const char*)Gb, (const char*)Wt2, FF, 64, 8, 8, 0, G, bx}; EpiResid E{x, ctx, X1, mods + 2 * DM, mods + NMOD + 2 * DM, 0.5f}; pg8::gemm_phase(lds, FF, S, E); }
    SEAM(4);
    if (IN(5)) norm_rows(X1, X1 + (size_t)SEQ * DM, MT, H, mixn, mods, 3, 4, gw, ngw, lane);
    SEAM(5);
    if (IN(6)) { GSched S{(const char*)H, (const char*)Wt3, DM, 64, 20, 4 + 4 * 65, 3, G, bx}; EpiInProj E{Qb, Kb, Vt, BG, Zb, qn, kn, ropec, ropes}; pg8::gemm_phase(lds, DM, S, E); }
    SEAM(6);
    if (IN(7)) {
        LAS float* tab = (LAS float*)(lds + wave * 4096);
        for (int u = gw; u < NH * 512; u += ngw) attn_unit(u, Qb, Kb, Vt, rpb, H, ssq, tab, lane);
        conv_rows(BG, Zb, convw, convb, onc, H, gw, ngw, lane);
    }
    SEAM(7);
    if (IN(8)) ynorm_rows(H, ssq, ona, gw, ngw, lane);
    SEAM(8);
    if (IN(9)) { GSched S{(const char*)H, (const char*)Wt4, DM, 64, 8, 0, 0, G, bx}; EpiResid E{X1, X1, X1, mods + 5 * DM, mods + 5 * DM, 1.0f}; pg8::gemm_phase(lds, DM, S, E); }
    SEAM(9);
    if (IN(10)) norm_rows(X1, X1, SEQ, H, ff2n, mods, 6, 7, gw, ngw, lane);
    SEAM(10);
    if (IN(11)) { GSched S{(const char*)H, (const char*)Wt5, DM, 64, 44, 0, 0, G, bx}; EpiSwiGLU E{Gb}; pg8::gemm_phase(lds, DM, S, E); }
    SEAM(11);
    if (IN(12)) { GSched S{(const char*)Gb, (const char*)Wt6, FF, 64, 8, 0, 0, G, bx}; EpiResid E{X1, X1, a.out, mods + 8 * DM, mods + 8 * DM, 0.5f}; pg8::gemm_phase(lds, FF, S, E); }
#undef IN
#undef SEAM
}

extern "C" void kernel_launch(void* const* d_in, const int* in_sizes, int n_in, void* d_out, int out_size, void* d_ws, size_t ws_size, hipStream_t stream) {
    static int grid = 0;
    if (grid == 0) {
        if (n_in != 22 || out_size != SEQ * DM || ws_size < WS_END) { fprintf(stderr, "kernel_launch: unexpected shapes (n_in %d out %d ws %zu)\n", n_in, out_size, ws_size); grid = -1; return; }
        int dev = 0, cus = 0, per_cu = 0;
        if (hipGetDevice(&dev) != hipSuccess || hipDeviceGetAttribute(&cus, hipDeviceAttributeMultiprocessorCount, dev) != hipSuccess) { grid = -1; return; }
        if (hipFuncSetAttribute((const void*)fwd, hipFuncAttributeMaxDynamicSharedMemorySize, LDS_BYTES) != hipSuccess) { fprintf(stderr, "kernel_launch: hipFuncSetAttribute failed\n"); grid = -1; return; }
        if (hipOccupancyMaxActiveBlocksPerMultiprocessor(&per_cu, (const void*)fwd, 512, LDS_BYTES) != hipSuccess || per_cu < 1) { fprintf(stderr, "kernel_launch: occupancy query says %d\n", per_cu); per_cu = 1; }
        (void)hipGetLastError();
        grid = cus;
    }
    if (grid < 0) return;
    Args a{};
    for (int i = 0; i < 22; ++i) a.in[i] = (const float*)d_in[i];
    a.out = (float*)d_out; a.ws = (unsigned char*)d_ws;
    if (MK_N_LAUNCHES == 1) {
        a.ph_lo = 0; a.ph_hi = NPHASE;
        void* args[] = {&a};
        hipError_t e = hipLaunchCooperativeKernel((const void*)fwd, dim3(grid), dim3(512), args, LDS_BYTES, stream);
        if (e != hipSuccess) fprintf(stderr, "cooperative launch failed: %s (grid %d)\n", hipGetErrorString(e), grid);
    } else {
        for (int p = 0; p < NPHASE; ++p) { a.ph_lo = p; a.ph_hi = p + 1; hipLaunchKernelGGL(fwd, dim3(grid), dim3(512), LDS_BYTES, stream, a); }
    }
}
```

```cpp
#include <hip/hip_runtime.h>
#include <cstdio>
#include <cstdint>

#define LAS __attribute__((address_space(3)))
typedef unsigned short bf16_t;
typedef short bf16x8 __attribute__((ext_vector_type(8)));
typedef float f32x4 __attribute__((ext_vector_type(4)));
typedef float f32x16 __attribute__((ext_vector_type(16)));
typedef unsigned u32x4 __attribute__((ext_vector_type(4)));
typedef unsigned u32x2 __attribute__((ext_vector_type(2)));

#ifndef PROBE_MASK
#define PROBE_MASK 0
#endif
#define REP(k) ((((PROBE_MASK) >> (k)) & 1) ? 2 : 1)
#ifndef MK_N_LAUNCHES
#define MK_N_LAUNCHES 1
#endif

constexpr int SEQ = 16384, CTX = 256, MT = SEQ + CTX, DM = 2048, FF = 5632, FF2 = 2 * FF, DIN = 6144, DA = 1024, NH = 16;
constexpr int NMOD = 9 * DM;
constexpr float EPS = 1e-6f, LOG2E = 1.4426950408889634f;
constexpr int KSPLIT = 32;

constexpr size_t MiB = 1u << 20;
constexpr size_t WS_MODS = 0;
constexpr size_t WS_ROPE = 256 * 1024;
constexpr size_t WS_MPART = 1 * MiB;
constexpr size_t WS_BAR = 512 * 1024;
constexpr size_t WS_SSQ = 6 * MiB;
constexpr size_t WS_WT1 = 8 * MiB, WS_WT2 = 52 * MiB, WS_WT3 = 74 * MiB, WS_WT4 = 98 * MiB, WS_WT5 = 106 * MiB, WS_WT6 = 150 * MiB;
constexpr size_t WS_H = 172 * MiB;
constexpr size_t WS_X1 = 237 * MiB;
constexpr size_t WS_G = 367 * MiB;
constexpr size_t WS_Q = 367 * MiB, WS_K = 399 * MiB, WS_VT = 432 * MiB, WS_BG = 465 * MiB, WS_Z = 497 * MiB;
constexpr size_t WS_END = 546 * MiB;

__device__ __forceinline__ unsigned cvt_pk_bf16(float lo, float hi) { unsigned r; asm("v_cvt_pk_bf16_f32 %0, %1, %2" : "=v"(r) : "v"(lo), "v"(hi)); return r; }
__device__ __forceinline__ float bf2f(unsigned short b) { return __builtin_bit_cast(float, (unsigned)b << 16); }
__device__ __forceinline__ float wave_sum(float v) {
#pragma unroll
    for (int o = 1; o < 64; o <<= 1) v += __shfl_xor(v, o);
    return v;
}
__device__ __forceinline__ float silu_f(float a) { return a * __builtin_amdgcn_rcpf(1.0f + __builtin_amdgcn_exp2f(-a * LOG2E)); }

namespace pg8 {
constexpr int BM = 256, BK = 64, HALF = 128, HTB = HALF * BK * 2, STAGE_BYTES = 8 * HTB, NXCD = 8, WGM = 8;
__host__ __device__ __forceinline__ int lds_byte(int r, int c) { const int st = (r >> 4) * 2 + (c >> 5), rr = r & 15, cc = c & 31, ob = rr * 64 + cc * 2; return st * 1024 + (ob ^ (((ob >> 9) & 1) << 5)); }
__host__ __device__ __forceinline__ void stage_rc(int b, int& R, int& C) { const int st = b / 1024, sb = b % 1024, swz = sb ^ (((sb >> 9) & 1) << 5); R = (st >> 1) * 16 + swz / 64; C = (st & 1) * 32 + (swz % 64) / 2; }
__host__ __device__ __forceinline__ int perm32(int rho) { const int n = rho >> 4, i = rho & 15; return 8 * (i >> 2) + 4 * n + (i & 3); }

struct Unit { int pm, pn, kind; const char* pa; const char* pb; };

template <class Epi, class Sched>
__device__ __forceinline__ void gemm_phase(LAS unsigned char* lds, const int K, const Sched& S, const Epi& E) {
    const int tid = threadIdx.x, wid = __builtin_amdgcn_readfirstlane(tid >> 6), lane = tid & 63, wr = wid >> 2, wc = wid & 3, fr = lane & 15, fq = lane >> 4;
    const int nt = K / BK;
    unsigned voffA[2], voffB[2];
#pragma unroll
    for (int i = 0; i < 2; ++i) { int R, C; stage_rc(tid * 16 + i * 8192, R, C); const int Rb = (R & ~31) + perm32(R & 31);
        voffA[i] = (unsigned)(R * K + C) * 2u; voffB[i] = (unsigned)(Rb * K + C) * 2u; }
    const size_t kstep = (size_t)(BK * 2);
    const size_t hstep = (size_t)HALF * K * 2;
    const unsigned ldsw = (unsigned)wid * 1024u;
    const int aoff = lds_byte(wr * 64 + fr, fq * 8), boff = lds_byte(wc * 32 + fr, fq * 8);
#define PG8_SA(b, h) (((b) * 2 + (h)) * HTB)
#define PG8_SB(b, h) ((4 + (b) * 2 + (h)) * HTB)
#define PG8_STAGE(bufoff, gbase, voff) do { _Pragma("unroll") for (int _i = 0; _i < 2; ++_i) \
        __builtin_amdgcn_global_load_lds((const unsigned*)((const char*)(gbase) + (voff)[_i]), (LAS unsigned*)(lds + (bufoff) + ldsw + _i * 8192), 16, 0, 0); } while (0)
#define PG8_LDA(dst, b, h) do { _Pragma("unroll") for (int m = 0; m < 4; ++m) _Pragma("unroll") for (int k = 0; k < 2; ++k) dst[m][k] = *(const LAS bf16x8*)(lds + PG8_SA(b, h) + aoff + m * 2048 + k * 1024); } while (0)
#define PG8_LDB(dst, b, h) do { _Pragma("unroll") for (int n = 0; n < 2; ++n) _Pragma("unroll") for (int k = 0; k < 2; ++k) dst[n][k] = *(const LAS bf16x8*)(lds + PG8_SB(b, h) + boff + n * 2048 + k * 1024); } while (0)
#define PG8_MMA(ai, bj, At, Bt) do { __builtin_amdgcn_s_setprio(1); _Pragma("unroll") for (int m = 0; m < 4; ++m) _Pragma("unroll") for (int n = 0; n < 2; ++n) _Pragma("unroll") for (int k = 0; k < 2; ++k) \
        acc[ai][bj][m][n] = __builtin_amdgcn_mfma_f32_16x16x32_bf16(Bt[n][k], At[m][k], acc[ai][bj][m][n], 0, 0, 0); __builtin_amdgcn_s_setprio(0); } while (0)
#define PG8_WAIT_V(n) asm volatile("s_waitcnt vmcnt(" #n ")" ::: "memory")
#define PG8_WAIT_L(n) asm volatile("s_waitcnt lgkmcnt(" #n ")" ::: "memory")
#define PG8_BAR __builtin_amdgcn_s_barrier()
#define PG8_SCHED __builtin_amdgcn_sched_barrier(0)
    Unit cur, nxt; int ui = 0;
    if (!S.next(0, cur)) return;
    f32x4 acc[2][2][4][2];
#pragma unroll
    for (int a = 0; a < 2; ++a)
#pragma unroll
        for (int b = 0; b < 2; ++b)
#pragma unroll
            for (int m = 0; m < 4; ++m)
#pragma unroll
                for (int n = 0; n < 2; ++n) acc[a][b][m][n] = (f32x4){0.f, 0.f, 0.f, 0.f};
    bf16x8 At[4][2], B0[2][2], B1[2][2];
    const char* cA = cur.pa; const char* cB = cur.pb;
    PG8_STAGE(PG8_SB(0, 0), cB, voffB); PG8_STAGE(PG8_SB(0, 1), cB + hstep, voffB); PG8_STAGE(PG8_SA(0, 0), cA, voffA); PG8_STAGE(PG8_SA(0, 1), cA + hstep, voffA);
    if (wr == 1) PG8_BAR;
    PG8_WAIT_V(2); PG8_BAR;
    PG8_STAGE(PG8_SB(1, 0), cB + kstep, voffB); PG8_STAGE(PG8_SA(1, 0), cA + kstep, voffA); PG8_STAGE(PG8_SB(1, 1), cB + hstep + kstep, voffB);
    PG8_WAIT_V(6); PG8_BAR;
    for (;;) {
        const bool has_next = S.next(ui + 1, nxt);
        const char* nA = has_next ? nxt.pa : cA; const char* nB = has_next ? nxt.pb : cB;
        for (int t = 0; t < nt; t += 2) {
            const bool last = (t == nt - 2);
            const char* a1 = cA + (size_t)(t + 1) * kstep;
            const char* a2 = last ? nA : cA + (size_t)(t + 2) * kstep; const char* b2 = last ? nB : cB + (size_t)(t + 2) * kstep;
            const char* a3 = a2 + kstep; const char* b3 = b2 + kstep;
            PG8_LDB(B0, 0, 0); PG8_LDB(B1, 0, 1); PG8_SCHED; PG8_LDA(At, 0, 0); PG8_STAGE(PG8_SA(1, 1), a1 + hstep, voffA);
            PG8_WAIT_V(8); PG8_WAIT_L(0); PG8_BAR; PG8_MMA(0, 0, At, B0); PG8_MMA(0, 1, At, B1); PG8_BAR; PG8_SCHED;
            PG8_LDA(At, 0, 1); PG8_STAGE(PG8_SB(0, 0), b2, voffB); PG8_STAGE(PG8_SB(0, 1), b2 + hstep, voffB); PG8_STAGE(PG8_SA(0, 0), a2, voffA);
            PG8_WAIT_V(8); PG8_WAIT_L(0); PG8_BAR; PG8_MMA(1, 0, At, B0); PG8_MMA(1, 1, At, B1); PG8_BAR; PG8_SCHED;
            PG8_LDB(B0, 1, 0); PG8_LDB(B1, 1, 1); PG8_SCHED; PG8_LDA(At, 1, 0); PG8_STAGE(PG8_SA(0, 1), a2 + hstep, voffA);
            PG8_WAIT_V(8); PG8_WAIT_L(0); PG8_BAR; PG8_MMA(0, 0, At, B0); PG8_MMA(0, 1, At, B1); PG8_BAR; PG8_SCHED;
            PG8_LDA(At, 1, 1); PG8_STAGE(PG8_SB(1, 0), b3, voffB); PG8_STAGE(PG8_SB(1, 1), b3 + hstep, voffB); PG8_STAGE(PG8_SA(1, 0), a3, voffA);
            PG8_WAIT_V(8); PG8_WAIT_L(0); PG8_BAR; PG8_MMA(1, 0, At, B0); PG8_MMA(1, 1, At, B1); PG8_BAR; PG8_SCHED;
        }
        if (wr == 0) PG8_BAR;
        E(acc, cur, wr, wc, fr, fq);
        if (!has_next) break;
#pragma unroll
        for (int a = 0; a < 2; ++a)
#pragma unroll
            for (int b = 0; b < 2; ++b)
#pragma unroll
                for (int m = 0; m < 4; ++m)
#pragma unroll
                    for (int n = 0; n < 2; ++n) acc[a][b][m][n] = (f32x4){0.f, 0.f, 0.f, 0.f};
        cur = nxt; cA = nA; cB = nB; ++ui;
        if (wr == 1) PG8_BAR;
    }
    PG8_WAIT_V(0);
    PG8_BAR;
#undef PG8_SA
#undef PG8_SB
#undef PG8_STAGE
#undef PG8_LDA
#undef PG8_LDB
#undef PG8_MMA
#undef PG8_WAIT_V
#undef PG8_WAIT_L
#undef PG8_BAR
#undef PG8_SCHED
}
}

enum { KQ = 0, KK = 1, KKCTX = 2, KBG = 3, KZ = 4, KVT = 5 };
struct GSched {
    const char* A; const char* B; int K, nM, nN, nX, mode, G, c;
    __device__ __forceinline__ bool next(int i, pg8::Unit& u) const {
        const int nwg = nM * nN; const long L = (long)i * G + c; if (L >= nwg + nX) return false;
        const size_t tstep = (size_t)256 * K * 2;
        if (L < nwg) {
            int wgid = (int)L; { const int q = nwg / pg8::NXCD, r = nwg % pg8::NXCD, xcd = wgid % pg8::NXCD, off = wgid / pg8::NXCD; wgid = (xcd < r ? xcd * (q + 1) : r * (q + 1) + (xcd - r) * q) + off; }
            const int nig = pg8::WGM * nN, gid = wgid / nig, fm = gid * pg8::WGM, gsz = (nM - fm) < pg8::WGM ? (nM - fm) : pg8::WGM;
            const int pm = fm + ((wgid % nig) % gsz), pi = (wgid % nig) / gsz;
            int pnB = pi, kind = 0;
            if (mode == 3) { pnB = pi < 8 ? pi : pi + 4; kind = pi < 4 ? KQ : pi < 8 ? KK : pi < 12 ? KBG : KZ; }
            u.pm = pm; u.pn = pnB; u.kind = kind; u.pa = A + (size_t)pm * tstep; u.pb = B + (size_t)pnB * tstep;
        } else {
            const int x = (int)(L - nwg);
            if (mode != 3) { u.pm = nM; u.pn = x; u.kind = 0; u.pa = A + (size_t)nM * tstep; u.pb = B + (size_t)x * tstep; }
            else if (x < 4) { u.pm = 64; u.pn = 4 + x; u.kind = KKCTX; u.pa = A + (size_t)64 * tstep; u.pb = B + (size_t)(4 + x) * tstep; }
            else { const int v = x - 4, pmv = v / 65, pnv = v % 65; u.pm = pmv; u.pn = pnv; u.kind = KVT; u.pa = B + (size_t)(8 + pmv) * tstep; u.pb = A + (size_t)pnv * tstep; }
        }
        return true;
    }
};

typedef f32x4 Acc[2][2][4][2];
struct EpiSwiGLU {
    bf16_t* G;
    __device__ __forceinline__ void operator()(const Acc& acc, const pg8::Unit& u, int wr, int wc, int fr, int fq) const {
        const int row0 = u.pm * 256 + wr * 64 + fr, col0 = u.pn * 128 + wc * 32 + 8 * fq;
#pragma unroll
        for (int ai = 0; ai < 2; ++ai)
#pragma unroll
            for (int m = 0; m < 4; ++m) {
                bf16_t* p = G + (size_t)(row0 + ai * 128 + m * 16) * FF + col0;
                const f32x4 a0 = acc[ai][0][m][0], a1 = acc[ai][0][m][1], b0 = acc[ai][1][m][0], b1 = acc[ai][1][m][1];
                u32x4 w;
                w.x = cvt_pk_bf16(silu_f(a0[0]) * b0[0], silu_f(a0[1]) * b0[1]); w.y = cvt_pk_bf16(silu_f(a0[2]) * b0[2], silu_f(a0[3]) * b0[3]);
                w.z = cvt_pk_bf16(silu_f(a1[0]) * b1[0], silu_f(a1[1]) * b1[1]); w.w = cvt_pk_bf16(silu_f(a1[2]) * b1[2], silu_f(a1[3]) * b1[3]);
                *(u32x4*)p = w;
            }
    }
};
struct EpiResid {
    const float* base_x; const float* base_c; float* out; const float* gate_x; const float* gate_c; float s;
    __device__ __forceinline__ void operator()(const Acc& acc, const pg8::Unit& u, int wr, int wc, int fr, int fq) const {
        const bool isc = u.pm >= 64;
        const float* base = isc ? base_c - (size_t)SEQ * DM : base_x; const float* gate = isc ? gate_c : gate_x;
        const int row0 = u.pm * 256 + wr * 64 + fr, col0 = u.pn * 256 + wc * 32 + 8 * fq;
        f32x4 gv[2][2];
#pragma unroll
        for (int bj = 0; bj < 2; ++bj)
#pragma unroll
            for (int n = 0; n < 2; ++n) gv[bj][n] = *(const f32x4*)(gate + col0 + bj * 128 + 4 * n) * s;
#pragma unroll
        for (int ai = 0; ai < 2; ++ai)
#pragma unroll
            for (int m = 0; m < 4; ++m) {
                const size_t off = (size_t)(row0 + ai * 128 + m * 16) * DM + col0;
#pragma unroll
                for (int bj = 0; bj < 2; ++bj)
#pragma unroll
                    for (int n = 0; n < 2; ++n) {
                        const f32x4 b = *(const f32x4*)(base + off + bj * 128 + 4 * n);
                        *(f32x4*)(out + off + bj * 128 + 4 * n) = b + gv[bj][n] * acc[ai][bj][m][n];
                    }
            }
    }
};
struct EpiInProj {
    bf16_t *Q, *Kb, *Vt, *BG, *Z; const float *qn, *kn, *rc, *rs;
    template <bool ROPE> __device__ __forceinline__ void qk(const Acc& acc, int row0, bf16_t* dst, int head, const float* gain, float oscale, int fq) const {
        f32x4 g[2][2];
#pragma unroll
        for (int bj = 0; bj < 2; ++bj)
#pragma unroll
            for (int n = 0; n < 2; ++n) g[bj][n] = *(const f32x4*)(gain + 32 * bj + 16 * n + 4 * fq);
#pragma unroll
        for (int ai = 0; ai < 2; ++ai)
#pragma unroll
            for (int m = 0; m < 4; ++m) {
                const int r = row0 + ai * 128 + m * 16;
                float ss = 0.f;
#pragma unroll
                for (int bj = 0; bj < 2; ++bj)
#pragma unroll
                    for (int n = 0; n < 2; ++n) { const f32x4 v = acc[ai][bj][m][n]; ss += (v[0] * v[0] + v[1] * v[1]) + (v[2] * v[2] + v[3] * v[3]); }
                ss += __shfl_xor(ss, 16); ss += __shfl_xor(ss, 32);
                const float rinv = __builtin_amdgcn_rsqf(ss * (1.0f / 64.0f) + EPS) * oscale;
                bf16_t* p = dst + (size_t)r * DA + head * 64 + 4 * fq;
#pragma unroll
                for (int bj = 0; bj < 2; ++bj) {
                    const f32x4 y0 = acc[ai][bj][m][0] * rinv * g[bj][0], y1 = acc[ai][bj][m][1] * rinv * g[bj][1];
                    f32x4 o1, o2;
                    if (ROPE) { const int pos = bj ? (r & 63) : (r >> 6);
                        const f32x4 C = *(const f32x4*)(rc + pos * 16 + 4 * fq), Sn = *(const f32x4*)(rs + pos * 16 + 4 * fq);
                        o1 = y0 * C - y1 * Sn; o2 = y0 * Sn + y1 * C; }
                    else { o1 = y0; o2 = y1; }
                    u32x2 w1, w2; w1.x = cvt_pk_bf16(o1[0], o1[1]); w1.y = cvt_pk_bf16(o1[2], o1[3]); w2.x = cvt_pk_bf16(o2[0], o2[1]); w2.y = cvt_pk_bf16(o2[2], o2[3]);
                    *(u32x2*)(p + 32 * bj) = w1; *(u32x2*)(p + 32 * bj + 16) = w2;
                }
            }
    }
    __device__ __forceinline__ void operator()(const Acc& acc, const pg8::Unit& u, int wr, int wc, int fr, int fq) const {
        const int row0 = u.pm * 256 + wr * 64 + fr;
        if (u.kind == KQ) { qk<true>(acc, row0, Q, 4 * u.pn + wc, qn, 0.125f * LOG2E, fq); }
        else if (u.kind == KK) { qk<true>(acc, row0, Kb, 4 * (u.pn - 4) + wc, kn, 1.0f, fq); }
        else if (u.kind == KKCTX) { qk<false>(acc, row0, Kb, 4 * (u.pn - 4) + wc, kn, 1.0f, fq); }
        else if (u.kind == KZ) {
            const int col0 = (u.pn - 16) * 128 + wc * 32 + 8 * fq;
#pragma unroll
            for (int ai = 0; ai < 2; ++ai)
#pragma unroll
                for (int m = 0; m < 4; ++m) {
                    const f32x4 z0 = acc[ai][0][m][0] * acc[ai][1][m][0], z1 = acc[ai][0][m][1] * acc[ai][1][m][1];
                    u32x4 w; w.x = cvt_pk_bf16(z0[0], z0[1]); w.y = cvt_pk_bf16(z0[2], z0[3]); w.z = cvt_pk_bf16(z1[0], z1[1]); w.w = cvt_pk_bf16(z1[2], z1[3]);
                    *(u32x4*)(Z + (size_t)(row0 + ai * 128 + m * 16) * DA + col0) = w;
                }
        } else {
            bf16_t* dst; size_t ld; int col0;
            if (u.kind == KBG) { dst = BG; ld = DA; col0 = (u.pn - 12) * 256 + wc * 32 + 8 * fq; }
            else { dst = Vt; ld = MT; col0 = u.pn * 256 + wc * 32 + 8 * fq; }
#pragma unroll
            for (int ai = 0; ai < 2; ++ai)
#pragma unroll
                for (int m = 0; m < 4; ++m)
#pragma unroll
                    for (int bj = 0; bj < 2; ++bj) {
                        const f32x4 v0 = acc[ai][bj][m][0], v1 = acc[ai][bj][m][1];
                        u32x4 w; w.x = cvt_pk_bf16(v0[0], v0[1]); w.y = cvt_pk_bf16(v0[2], v0[3]); w.z = cvt_pk_bf16(v1[0], v1[1]); w.w = cvt_pk_bf16(v1[2], v1[3]);
                        *(u32x4*)(dst + (size_t)(row0 + ai * 128 + m * 16) * ld + col0 + bj * 128) = w;
                    }
        }
    }
};

__device__ __forceinline__ int colmap(int mode, int np) {
    if (mode == 1) { const int tile = np >> 8, w = np & 255; return (w >> 7) * FF + tile * 128 + (w & 127); }
    if (mode == 3) {
        if (np < 2048) { const int base = np & ~1023, rel = np & 1023, tile = rel >> 8, w = rel & 255;
            const int bj = w >> 7, wc = (w >> 5) & 3, fq = (w >> 3) & 3, n = (w >> 2) & 1, e = w & 3;
            return base + 64 * (4 * tile + wc) + 32 * bj + 16 * n + 4 * fq + e; }
        if (np < 4096) return np;
        const int rel = np - 4096, tile = rel >> 8, w = rel & 255; return ((w >> 7) ? 5120 : 4096) + tile * 128 + (w & 127);
    }
    return np;
}
__device__ __forceinline__ void transpose_item(const float* W, int K, int N, bf16_t* Wt, int mode, int item, int lane) {
    const int nblk = N / 32, kb = item / nblk, nb = item % nblk;
    const int ns = lane & 7, kg = lane >> 3, np0 = nb * 32 + 4 * ns, c0 = colmap(mode, np0), k0 = kb * 64 + 8 * kg;
    f32x4 v[8];
#pragma unroll
    for (int j = 0; j < 8; ++j) v[j] = *(const f32x4*)(W + (size_t)(k0 + j) * N + c0);
#pragma unroll
    for (int e = 0; e < 4; ++e) { u32x4 w; w.x = cvt_pk_bf16(v[0][e], v[1][e]); w.y = cvt_pk_bf16(v[2][e], v[3][e]); w.z = cvt_pk_bf16(v[4][e], v[5][e]); w.w = cvt_pk_bf16(v[6][e], v[7][e]);
        *(u32x4*)(Wt + (size_t)(np0 + e) * K + k0) = w; }
}
__device__ __forceinline__ void ada_item(const float* wada, const float* cvec, const float* cctx, float* part, int item, int lane) {
    const int ks = item / 72, cc = item % 72;
    const float sx = silu_f(cvec[ks * 64 + lane]), sc = silu_f(cctx[ks * 64 + lane]);
    f32x4 ax = {0.f, 0.f, 0.f, 0.f}, ac = {0.f, 0.f, 0.f, 0.f};
    const float* wp = wada + (size_t)(ks * 64) * NMOD + cc * 256 + 4 * lane;
#pragma unroll 16
    for (int k = 0; k < 64; ++k) { const f32x4 w = *(const f32x4*)(wp + (size_t)k * NMOD);
        const float a = __builtin_bit_cast(float, __builtin_amdgcn_readlane(__builtin_bit_cast(int, sx), k)), b = __builtin_bit_cast(float, __builtin_amdgcn_readlane(__builtin_bit_cast(int, sc), k));
        ax += w * a; ac += w * b; }
    *(f32x4*)(part + (size_t)(ks * 2 + 0) * NMOD + cc * 256 + 4 * lane) = ax;
    *(f32x4*)(part + (size_t)(ks * 2 + 1) * NMOD + cc * 256 + 4 * lane) = ac;
}
__device__ __forceinline__ void norm_rows(const float* src_x, const float* src_c, int nrows, bf16_t* H, const float* g, const float* mods, int ishift, int iscale, int gw, int ngw, int lane) {
    for (int m = gw; m < nrows; m += ngw) {
        const bool isc = m >= SEQ;
        const float* src = isc ? src_c + (size_t)(m - SEQ) * DM : src_x + (size_t)m * DM; const float* md = mods + (isc ? NMOD : 0);
        f32x4 v[8]; float ss = 0.f;
#pragma unroll
        for (int j = 0; j < 8; ++j) { v[j] = *(const f32x4*)(src + 4 * lane + 256 * j); ss += (v[j][0] * v[j][0] + v[j][1] * v[j][1]) + (v[j][2] * v[j][2] + v[j][3] * v[j][3]); }
        const float rinv = __builtin_amdgcn_rsqf(wave_sum(ss) * (1.0f / DM) + EPS);
#pragma unroll
        for (int j = 0; j < 8; ++j) { const int c = 4 * lane + 256 * j;
            const f32x4 gg = *(const f32x4*)(g + c), sc = *(const f32x4*)(md + iscale * DM + c), sh = *(const f32x4*)(md + ishift * DM + c);
            const f32x4 h = v[j] * rinv * gg * (sc + 1.0f) + sh;
            u32x2 w; w.x = cvt_pk_bf16(h[0], h[1]); w.y = cvt_pk_bf16(h[2], h[3]);
            *(u32x2*)(H + (size_t)m * DM + c) = w; }
    }
}

__device__ __forceinline__ void attn_unit(int u, const bf16_t* Q, const bf16_t* Kb, const bf16_t* Vt, const float* rpb, bf16_t* Y, float* ssq, LAS float* tab, int lane) {
    const int h = u >> 9, tile = u & 511, rp = tile >> 2, cg = tile & 3;
    const int ql = lane & 31, hi = lane >> 5;
    const int r0 = 2 * rp, qr = r0 + (ql >> 4), qc = 16 * cg + (ql & 15), qtok = qr * 64 + qc;
    for (int i = lane; i < 465; i += 64) tab[64 + i] = rpb[h * 465 + i] * LOG2E;
    bf16x8 qf[4];
#pragma unroll
    for (int c = 0; c < 4; ++c) qf[c] = *(const bf16x8*)(Q + (size_t)qtok * DA + h * 64 + 16 * c + 8 * hi);
    const int rs_q = min(max(qr - 4, 0), 248), cs_q = min(max(qc - 8, 0), 48);
    const int rs0 = min(max(r0 - 4, 0), 248), rs1 = min(max(r0 - 3, 0), 248);
    const int nblk = 8 + ((rs1 != rs0) ? 9 : 8);
    const int kc0 = min(max(16 * cg - 8, 0), 32);
    const int kap = (ql & 19) | ((ql & 4) << 1) | ((ql & 8) >> 1);
    const bf16_t* kbase = Kb + (size_t)kap * DA + h * 64 + 8 * hi;
    const bf16_t* vbase = Vt + (size_t)(h * 64 + ql) * MT + 8 * hi;
    f32x16 o0, o1;
#pragma unroll
    for (int i = 0; i < 16; ++i) { o0[i] = 0.f; o1[i] = 0.f; }
    float mrun = -1e30f, lrun = 0.f;
    asm volatile("s_waitcnt lgkmcnt(0)" ::: "memory");
    bf16x8 kf[4], vf[4], kn[4], vn[4];
    { const int tok0 = SEQ;
#pragma unroll
      for (int c = 0; c < 4; ++c) kn[c] = *(const bf16x8*)(kbase + (size_t)tok0 * DA + 16 * c);
#pragma unroll
      for (int d = 0; d < 2; ++d)
#pragma unroll
          for (int t = 0; t < 2; ++t) vn[d * 2 + t] = *(const bf16x8*)(vbase + (size_t)(32 * d) * MT + tok0 + 16 * t); }
    for (int b = 0; b < nblk; ++b) {
#pragma unroll
        for (int c = 0; c < 4; ++c) { kf[c] = kn[c]; vf[c] = vn[c]; }
        if (b + 1 < nblk) { const int bn = b + 1; const int tok0 = bn < 8 ? SEQ + 32 * bn : (rs0 + bn - 8) * 64 + kc0;
#pragma unroll
            for (int c = 0; c < 4; ++c) kn[c] = *(const bf16x8*)(kbase + (size_t)tok0 * DA + 16 * c);
#pragma unroll
            for (int d = 0; d < 2; ++d)
#pragma unroll
                for (int t = 0; t < 2; ++t) vn[d * 2 + t] = *(const bf16x8*)(vbase + (size_t)(32 * d) * MT + tok0 + 16 * t); }
        f32x16 s;
#pragma unroll
        for (int i = 0; i < 16; ++i) s[i] = 0.f;
#pragma unroll
        for (int c = 0; c < 4; ++c) s = __builtin_amdgcn_mfma_f32_32x32x16_bf16(kf[c], qf[c], s, 0, 0, 0);
        if (b >= 8) {
            const int kr = rs0 + b - 8;
            const bool row_ok = (kr >= rs_q) && (kr < rs_q + 8);
            const int lo = cs_q - kc0 - 8 * hi;
            const int bi = 64 + (kr - qr + 7) * 31 + (kc0 + 8 * hi - qc + 15);
#pragma unroll
            for (int i = 0; i < 16; ++i) { const int j = 16 * (i >> 3) + 4 * ((i >> 2) & 1) + (i & 3);
                const bool ok = row_ok && (j >= lo) && (j < lo + 16);
                const float bias = tab[bi + j];
                s[i] = ok ? s[i] + bias : -1e30f; }
        }
        float bm = s[0];
#pragma unroll
        for (int i = 1; i < 16; ++i) bm = fmaxf(bm, s[i]);
        bm = fmaxf(bm, __shfl_xor(bm, 32));
        const float mnew = fmaxf(mrun, bm), alpha = __builtin_amdgcn_exp2f(mrun - mnew);
        mrun = mnew;
        float ps = 0.f;
#pragma unroll
        for (int i = 0; i < 16; ++i) { s[i] = __builtin_amdgcn_exp2f(s[i] - mnew); ps += s[i]; }
        lrun = lrun * alpha + ps;
#pragma unroll
        for (int i = 0; i < 16; ++i) { o0[i] *= alpha; o1[i] *= alpha; }
        u32x4 p0, p1;
        p0.x = cvt_pk_bf16(s[0], s[1]); p0.y = cvt_pk_bf16(s[2], s[3]); p0.z = cvt_pk_bf16(s[4], s[5]); p0.w = cvt_pk_bf16(s[6], s[7]);
        p1.x = cvt_pk_bf16(s[8], s[9]); p1.y = cvt_pk_bf16(s[10], s[11]); p1.z = cvt_pk_bf16(s[12], s[13]); p1.w = cvt_pk_bf16(s[14], s[15]);
        const bf16x8 pb0 = __builtin_bit_cast(bf16x8, p0), pb1 = __builtin_bit_cast(bf16x8, p1);
        o0 = __builtin_amdgcn_mfma_f32_32x32x16_bf16(vf[0], pb0, o0, 0, 0, 0);
        o0 = __builtin_amdgcn_mfma_f32_32x32x16_bf16(vf[1], pb1, o0, 0, 0, 0);
        o1 = __builtin_amdgcn_mfma_f32_32x32x16_bf16(vf[2], pb0, o1, 0, 0, 0);
        o1 = __builtin_amdgcn_mfma_f32_32x32x16_bf16(vf[3], pb1, o1, 0, 0, 0);
    }
    const float ltot = lrun + __shfl_xor(lrun, 32), inv = 1.0f / ltot;
    float sq = 0.f;
    bf16_t* yp = Y + (size_t)qtok * DM + h * 64 + 4 * hi;
#pragma unroll
    for (int a = 0; a < 4; ++a) {
        const float x0 = o0[4 * a] * inv, x1 = o0[4 * a + 1] * inv, x2 = o0[4 * a + 2] * inv, x3 = o0[4 * a + 3] * inv;
        const float y0 = o1[4 * a] * inv, y1 = o1[4 * a + 1] * inv, y2 = o1[4 * a + 2] * inv, y3 = o1[4 * a + 3] * inv;
        sq += (x0 * x0 + x1 * x1) + (x2 * x2 + x3 * x3) + (y0 * y0 + y1 * y1) + (y2 * y2 + y3 * y3);
        u32x2 w0, w1; w0.x = cvt_pk_bf16(x0, x1); w0.y = cvt_pk_bf16(x2, x3); w1.x = cvt_pk_bf16(y0, y1); w1.y = cvt_pk_bf16(y2, y3);
        *(u32x2*)(yp + 8 * a) = w0; *(u32x2*)(yp + 32 + 8 * a) = w1;
    }
    sq += __shfl_xor(sq, 32);
    if (hi == 0) ssq[h * SEQ + qtok] = sq;
}

__device__ __forceinline__ void conv_rows(const bf16_t* BG, const bf16_t* Z, const float* cw, const float* cb, const float* gc, bf16_t* Y, int gw, int ngw, int lane) {
    for (int t = gw; t < SEQ; t += ngw) {
        float val[16]; float ss = 0.f;
#pragma unroll
        for (int hf = 0; hf < 2; ++hf) {
            const int ch = 512 * hf + 8 * lane;
            const bf16x8 bg = *(const bf16x8*)(BG + (size_t)t * DA + ch), z1 = *(const bf16x8*)(Z + (size_t)t * DA + ch);
            bf16x8 z0 = {0, 0, 0, 0, 0, 0, 0, 0}, z2 = {0, 0, 0, 0, 0, 0, 0, 0};
            if (t > 0) z0 = *(const bf16x8*)(Z + (size_t)(t - 1) * DA + ch);
            if (t < SEQ - 1) z2 = *(const bf16x8*)(Z + (size_t)(t + 1) * DA + ch);
#pragma unroll
            for (int q4 = 0; q4 < 2; ++q4) {
                const f32x4 w0 = *(const f32x4*)(cw + ch + 4 * q4), w1 = *(const f32x4*)(cw + DA + ch + 4 * q4), w2 = *(const f32x4*)(cw + 2 * DA + ch + 4 * q4), bb = *(const f32x4*)(cb + ch + 4 * q4);
#pragma unroll
                for (int e = 0; e < 4; ++e) { const int i = 4 * q4 + e;
                    const float y = bb[e] + w0[e] * bf2f((unsigned short)z0[i]) + w1[e] * bf2f((unsigned short)z1[i]) + w2[e] * bf2f((unsigned short)z2[i]);
                    const float cv = bf2f((unsigned short)bg[i]) * y; val[8 * hf + i] = cv; ss += cv * cv; }
            }
        }
        const float rinv = __builtin_amdgcn_rsqf(wave_sum(ss) * (1.0f / DA) + EPS);
#pragma unroll
        for (int hf = 0; hf < 2; ++hf) {
            const int ch = 512 * hf + 8 * lane;
            const f32x4 g0 = *(const f32x4*)(gc + ch), g1 = *(const f32x4*)(gc + ch + 4);
            u32x4 w; w.x = cvt_pk_bf16(val[8 * hf + 0] * rinv * g0[0], val[8 * hf + 1] * rinv * g0[1]); w.y = cvt_pk_bf16(val[8 * hf + 2] * rinv * g0[2], val[8 * hf + 3] * rinv * g0[3]);
            w.z = cvt_pk_bf16(val[8 * hf + 4] * rinv * g1[0], val[8 * hf + 5] * rinv * g1[1]); w.w = cvt_pk_bf16(val[8 * hf + 6] * rinv * g1[2], val[8 * hf + 7] * rinv * g1[3]);
            *(u32x4*)(Y + (size_t)t * DM + DA + ch) = w;
        }
    }
}
__device__ __forceinline__ void ynorm_rows(bf16_t* Y, const float* ssq, const float* ga, int gw, int ngw, int lane) {
    for (int t = gw; t < SEQ; t += ngw) {
        const float part = lane < NH ? ssq[lane * SEQ + t] : 0.f;
        const float rinv = __builtin_amdgcn_rsqf(wave_sum(part) * (1.0f / DA) + EPS);
#pragma unroll
        for (int hf = 0; hf < 2; ++hf) {
            const int ch = 512 * hf + 8 * lane;
            const bf16x8 a = *(const bf16x8*)(Y + (size_t)t * DM + ch);
            const f32x4 g0 = *(const f32x4*)(ga + ch), g1 = *(const f32x4*)(ga + ch + 4);
            u32x4 w; w.x = cvt_pk_bf16(bf2f((unsigned short)a[0]) * rinv * g0[0], bf2f((unsigned short)a[1]) * rinv * g0[1]); w.y = cvt_pk_bf16(bf2f((unsigned short)a[2]) * rinv * g0[2], bf2f((unsigned short)a[3]) * rinv * g0[3]);
            w.z = cvt_pk_bf16(bf2f((unsigned short)a[4]) * rinv * g1[0], bf2f((unsigned short)a[5]) * rinv * g1[1]); w.w = cvt_pk_bf16(bf2f((unsigned short)a[6]) * rinv * g1[2], bf2f((unsigned short)a[7]) * rinv * g1[3]);
            *(u32x4*)(Y + (size_t)t * DM + ch) = w;
        }
    }
}


#define XB_TMO      128
#define XB_XCNT(j)  (256  + 64 * (j))
#define XB_XSUB(j)  (1280 + 64 * (j))
#define XB_XGEN(j)  (2304 + 64 * (j))
#define XB_TOP      3328
#define XB_TOPGEN   3392
#define XCD_BAR_WORDS 3456
#define XB_SPIN_CAP (1u << 18)
__device__ __forceinline__ unsigned xb_ld(unsigned* p)              { return __hip_atomic_load(p, __ATOMIC_RELAXED, __HIP_MEMORY_SCOPE_AGENT); }
__device__ __forceinline__ unsigned xb_add(unsigned* p, unsigned v) { return __hip_atomic_fetch_add(p, v, __ATOMIC_RELAXED, __HIP_MEMORY_SCOPE_AGENT); }
__device__ __forceinline__ unsigned xb_xcc_id() { return (unsigned)__builtin_amdgcn_s_getreg((3 << 11) | 20) & 0xFu; }
#define XB_SPIN(cond, bar) do { unsigned _sp = 0; while (cond) { __builtin_amdgcn_s_sleep(1); \
    if ((++_sp & 255u) == 0u) { if (xb_ld(&(bar)[XB_TMO])) break; if (_sp > XB_SPIN_CAP) { atomicAdd(&(bar)[XB_TMO], 1u); break; } } } } while (0)
struct XcdBarrier { unsigned* bar; unsigned x; volatile LAS unsigned* st; };
__device__ __forceinline__ XcdBarrier xcd_barrier_post(unsigned* bar, volatile LAS unsigned* st) {
    XcdBarrier b; b.bar = bar; b.x = xb_xcc_id(); b.st = st;
    if (threadIdx.x == 0) (void)xb_add(&bar[XB_XCNT(b.x)], 1u);
    return b;
}
__device__ __forceinline__ void xcd_barrier_complete(unsigned* bar, unsigned x, unsigned& nloc, unsigned& nx) {
    const unsigned G = gridDim.x * gridDim.y * gridDim.z;
    unsigned sum, cnt, mine, sp = 0u;
    for (;;) {
        sum = 0u; cnt = 0u; mine = 0u;
#pragma unroll
        for (unsigned j = 0; j < 16; ++j) { const unsigned c = xb_ld(&bar[XB_XCNT(j)]); sum += c; cnt += (c > 0u) ? 1u : 0u; mine = (j == x) ? c : mine; }
        if (sum == G) break;
        __builtin_amdgcn_s_sleep(1);
        if ((++sp & 255u) == 0u) { if (xb_ld(&bar[XB_TMO])) break; if (sp > XB_SPIN_CAP) { atomicAdd(&bar[XB_TMO], 1u); break; } }
    }
    nloc = mine > 0u ? mine : 1u; nx = cnt > 0u ? cnt : 1u;
}
__device__ __forceinline__ void xcd_barrier(const XcdBarrier& b) {
    asm volatile("s_waitcnt vmcnt(0)" ::: "memory");
    __syncthreads();
    if (threadIdx.x == 0) {
        unsigned* bar = b.bar;
        __builtin_amdgcn_s_waitcnt(0);
        unsigned nloc = b.st[0], nx = b.st[1];
        if (nloc == 0u) { xcd_barrier_complete(bar, b.x, nloc, nx); b.st[0] = nloc; b.st[1] = nx; }
        const unsigned old = xb_add(&bar[XB_XSUB(b.x)], 1u);
        const unsigned gen = old / nloc;
        if (old + 1u == (gen + 1u) * nloc) {
            __builtin_amdgcn_fence(__ATOMIC_RELEASE, "agent");
            asm volatile("s_waitcnt vmcnt(0)" ::: "memory");
            const unsigned og = xb_add(&bar[XB_TOP], 1u);
            const unsigned tg = og / nx;
            if (og + 1u == (tg + 1u) * nx) xb_add(&bar[XB_TOPGEN], 1u);
            else XB_SPIN(xb_ld(&bar[XB_TOPGEN]) == tg, bar);
            __builtin_amdgcn_fence(__ATOMIC_ACQUIRE, "agent");
            xb_add(&bar[XB_XGEN(b.x)], 1u);
            asm volatile("s_waitcnt vmcnt(0)" ::: "memory");
        } else {
            XB_SPIN(xb_ld(&bar[XB_XGEN(b.x)]) == gen, bar);
            __builtin_amdgcn_fence(__ATOMIC_ACQUIRE, "agent");
            asm volatile("s_waitcnt vmcnt(0)" ::: "memory");
        }
    }
    __syncthreads();
}

constexpr int NPHASE = 13;
constexpr int LDS_BYTES = 147456;
struct Args { const float* in[22]; float* out; unsigned char* ws; int ph_lo, ph_hi; };

__global__ void __launch_bounds__(512, 2) fwd(Args a) {
    extern __shared__ __attribute__((aligned(16))) unsigned char lds_raw[];
    LAS unsigned char* lds = (LAS unsigned char*)lds_raw;
    const int tid = threadIdx.x, lane = tid & 63, wave = __builtin_amdgcn_readfirstlane(tid >> 6);
    const int G = gridDim.x, bx = blockIdx.x;
    const int vcu = (G % 8 == 0) ? (bx % 8) * (G / 8) + bx / 8 : bx;
    const int gw = vcu * 8 + wave, ngw = G * 8;
    unsigned char* ws = a.ws;
    const float *x = a.in[0], *cvec = a.in[1], *ctx = a.in[2], *cctx = a.in[3], *wada = a.in[4], *bada = a.in[5], *ff1n = a.in[6], *ff1wi = a.in[7], *ff1wo = a.in[8],
                *mixn = a.in[9], *win = a.in[10], *qn = a.in[11], *kn = a.in[12], *rpb = a.in[13], *convw = a.in[14], *convb = a.in[15], *ona = a.in[16], *onc = a.in[17],
                *wout = a.in[18], *ff2n = a.in[19], *ff2wi = a.in[20], *ff2wo = a.in[21];
    float* mods = (float*)(ws + WS_MODS); float* ropec = (float*)(ws + WS_ROPE); float* ropes = ropec + 256 * 16; float* mpart = (float*)(ws + WS_MPART); float* ssq = (float*)(ws + WS_SSQ);
    bf16_t *Wt1 = (bf16_t*)(ws + WS_WT1), *Wt2 = (bf16_t*)(ws + WS_WT2), *Wt3 = (bf16_t*)(ws + WS_WT3), *Wt4 = (bf16_t*)(ws + WS_WT4), *Wt5 = (bf16_t*)(ws + WS_WT5), *Wt6 = (bf16_t*)(ws + WS_WT6);
    bf16_t *H = (bf16_t*)(ws + WS_H), *Gb = (bf16_t*)(ws + WS_G), *Qb = (bf16_t*)(ws + WS_Q), *Kb = (bf16_t*)(ws + WS_K), *Vt = (bf16_t*)(ws + WS_VT), *BG = (bf16_t*)(ws + WS_BG), *Zb = (bf16_t*)(ws + WS_Z);
    float* X1 = (float*)(ws + WS_X1);
    const int lo = a.ph_lo, hi = a.ph_hi;
    volatile LAS unsigned* MISC = (volatile LAS unsigned*)(lds + 131072 + 320);
    if (tid < 32) MISC[tid] = 0u;
    __syncthreads();
    unsigned* barw = (unsigned*)(ws + WS_BAR);
    XcdBarrier bar; bar.bar = barw; bar.x = 0; bar.st = MISC + 8;
#define IN(k) (lo <= (k) && (k) < hi)
#define SEAM(k) do { if (IN(k) && IN((k) + 1)) xcd_barrier(bar); } while (0)

    if (IN(0)) for (int rep = 0; rep < REP(0); ++rep) {
        constexpr int I_ADA = KSPLIT * 72, I_1 = (DM / 64) * (FF2 / 32), I_2 = (FF / 64) * (DM / 32), I_3 = (DM / 64) * (DIN / 32), I_4 = (DM / 64) * (DM / 32);
        constexpr int NIT = I_ADA + 2 * (I_1 + I_2) + I_3 + I_4;
        for (int it = gw; it < NIT; it += ngw) {
            int r = it;
            if (r < I_ADA) { ada_item(wada, cvec, cctx, mpart, r, lane); continue; } r -= I_ADA;
            if (r < I_1) { transpose_item(ff1wi, DM, FF2, Wt1, 1, r, lane); continue; } r -= I_1;
            if (r < I_2) { transpose_item(ff1wo, FF, DM, Wt2, 0, r, lane); continue; } r -= I_2;
            if (r < I_3) { transpose_item(win, DM, DIN, Wt3, 3, r, lane); continue; } r -= I_3;
            if (r < I_4) { transpose_item(wout, DM, DM, Wt4, 0, r, lane); continue; } r -= I_4;
            if (r < I_1) { transpose_item(ff2wi, DM, FF2, Wt5, 1, r, lane); continue; } r -= I_1;
            transpose_item(ff2wo, FF, DM, Wt6, 0, r, lane);
        }
    }
    if (IN(0) && IN(1)) {
        if (bx == 0) for (int i = tid; i < XCD_BAR_WORDS; i += 512) __hip_atomic_store(barw + i, 0u, __ATOMIC_RELAXED, __HIP_MEMORY_SCOPE_AGENT);
        asm volatile("s_waitcnt vmcnt(0)" ::: "memory");
        __ockl_grid_sync();
        bar = xcd_barrier_post(barw, MISC + 8);
    }
    if (IN(1)) for (int rep = 0; rep < REP(1); ++rep) {
        const int gt = bx * 512 + tid;
        if (gt < 2 * NMOD / 4) { const int v = gt / (NMOD / 4), j = (gt % (NMOD / 4)) * 4;
            f32x4 s = *(const f32x4*)(bada + j);
            for (int ks = 0; ks < KSPLIT; ++ks) s += *(const f32x4*)(mpart + (size_t)(ks * 2 + v) * NMOD + j);
            *(f32x4*)(mods + v * NMOD + j) = s; }
        else if (gt < 2 * NMOD / 4 + 4096) { const int idx = gt - 2 * NMOD / 4, pos = idx >> 4, i = idx & 15;
            const int i3 = i & 3; const float base4 = i3 == 0 ? 1.0f : i3 == 1 ? 0.5623413251903491f : i3 == 2 ? 0.31622776601683794f : 0.1778279410038923f;
            const int i2 = i >> 2; const float dec = i2 == 0 ? 1.0f : i2 == 1 ? 0.1f : i2 == 2 ? 0.01f : 0.001f;
            const float inv = base4 * dec;
            const float angf = (float)pos * inv;
            const double ang = (double)angf;
            const double r = ang - 6.283185307179586 * __builtin_rint(ang * 0.15915494309189535);
            const double r2 = r * r; double sn = r, cs = 1.0, ts = r, tc = 1.0;
#pragma unroll
            for (int k = 1; k <= 12; ++k) { tc = -tc * r2 / (double)((2 * k - 1) * (2 * k)); cs += tc; ts = -ts * r2 / (double)((2 * k) * (2 * k + 1)); sn += ts; }
            ropec[idx] = (float)cs; ropes[idx] = (float)sn; }
    }
    SEAM(1);
    if (IN(2)) for (int rep = 0; rep < REP(2); ++rep) norm_rows(x, ctx, MT, H, ff1n, mods, 0, 1, gw, ngw, lane);
    SEAM(2);
    if (IN(3)) for (int rep = 0; rep < REP(3); ++rep) { GSched S{(const char*)H, (const char*)Wt1, DM, 64, 44, 44, 0, G, bx}; EpiSwiGLU E{Gb}; pg8::gemm_phase(lds, DM, S, E); }
    SEAM(3);
    if (IN(4)) for (int rep = 0; rep < REP(4); ++rep) { GSched S{(const char*)Gb, (const char*)Wt2, FF, 64, 8, 8, 0, G, bx}; EpiResid E{x, ctx, X1, mods + 2 * DM, mods + NMOD + 2 * DM, 0.5f}; pg8::gemm_phase(lds, FF, S, E); }
    SEAM(4);
    if (IN(5)) for (int rep = 0; rep < REP(5); ++rep) norm_rows(X1, X1 + (size_t)SEQ * DM, MT, H, mixn, mods, 3, 4, gw, ngw, lane);
    SEAM(5);
    if (IN(6)) for (int rep = 0; rep < REP(6); ++rep) { GSched S{(const char*)H, (const char*)Wt3, DM, 64, 20, 4 + 4 * 65, 3, G, bx}; EpiInProj E{Qb, Kb, Vt, BG, Zb, qn, kn, ropec, ropes}; pg8::gemm_phase(lds, DM, S, E); }
    SEAM(6);
    if (IN(7)) for (int rep = 0; rep < REP(7); ++rep) {
        LAS float* tab = (LAS float*)(lds + wave * 4096);
        for (int u = gw; u < NH * 512; u += ngw) attn_unit(u, Qb, Kb, Vt, rpb, H, ssq, tab, lane);
        conv_rows(BG, Zb, convw, convb, onc, H, gw, ngw, lane);
    }
    SEAM(7);
    if (IN(8)) for (int rep = 0; rep < REP(8); ++rep) ynorm_rows(H, ssq, ona, gw, ngw, lane);
    SEAM(8);
    if (IN(9)) for (int rep = 0; rep < REP(9); ++rep) { GSched S{(const char*)H, (const char*)Wt4, DM, 64, 8, 0, 0, G, bx}; EpiResid E{X1, X1, X1, mods + 5 * DM, mods + 5 * DM, 1.0f}; pg8::gemm_phase(lds, DM, S, E); }
    SEAM(9);
    if (IN(10)) for (int rep = 0; rep < REP(10); ++rep) norm_rows(X1, X1, SEQ, H, ff2n, mods, 6, 7, gw, ngw, lane);
    SEAM(10);
    if (IN(11)) for (int rep = 0; rep < REP(11); ++rep) { GSched S{(const char*)H, (const char*)Wt5, DM, 64, 44, 0, 0, G, bx}; EpiSwiGLU E{Gb}; pg8::gemm_phase(lds, DM, S, E); }
    SEAM(11);
    if (IN(12)) for (int rep = 0; rep < REP(12); ++rep) { GSched S{(const char*)Gb, (const char*)Wt6, FF, 64, 8, 0, 0, G, bx}; EpiResid E{X1, X1, a.out, mods + 8 * DM, mods + 8 * DM, 0.5f}; pg8::gemm_phase(lds, FF, S, E); }
#undef IN
#undef SEAM
}

extern "C" void kernel_launch(void* const* d_in, const int* in_sizes, int n_in, void* d_out, int out_size, void* d_ws, size_t ws_size, hipStream_t stream) {
    static int grid = 0;
    if (grid == 0) {
        if (n_in != 22 || out_size != SEQ * DM || ws_size < WS_END) { fprintf(stderr, "kernel_launch: unexpected shapes (n_in %d out %d ws %zu)\n", n_in, out_size, ws_size); grid = -1; return; }
        int dev = 0, cus = 0, per_cu = 0;
        if (hipGetDevice(&dev) != hipSuccess || hipDeviceGetAttribute(&cus, hipDeviceAttributeMultiprocessorCount, dev) != hipSuccess) { grid = -1; return; }
        if (hipFuncSetAttribute((const void*)fwd, hipFuncAttributeMaxDynamicSharedMemorySize, LDS_BYTES) != hipSuccess) { fprintf(stderr, "kernel_launch: hipFuncSetAttribute failed\n"); grid = -1; return; }
        if (hipOccupancyMaxActiveBlocksPerMultiprocessor(&per_cu, (const void*)fwd, 512, LDS_BYTES) != hipSuccess || per_cu < 1) { fprintf(stderr, "kernel_launch: occupancy query says %d\n", per_cu); per_cu = 1; }
        (void)hipGetLastError();
        grid = cus;
    }
    if (grid < 0) return;
    Args a{};
    for (int i = 0; i < 22; ++i) a.in[i] = (const float*)d_in[i];
    a.out = (float*)d_out; a.ws = (unsigned char*)d_ws;
    if (MK_N_LAUNCHES == 1) {
        a.ph_lo = 0; a.ph_hi = NPHASE;
        void* args[] = {&a};
        hipError_t e = hipLaunchCooperativeKernel((const void*)fwd, dim3(grid), dim3(512), args, LDS_BYTES, stream);
        if (e != hipSuccess) fprintf(stderr, "cooperative launch failed: %s (grid %d)\n", hipGetErrorString(e), grid);
    } else {
        for (int p = 0; p < NPHASE; ++p) { a.ph_lo = p; a.ph_hi = p + 1; hipLaunchKernelGGL(fwd, dim3(grid), dim3(512), LDS_BYTES, stream, a); }
    }
}
```

```cpp
#include <hip/hip_runtime.h>
#include <cstdio>
#include <cstdint>

#define LAS __attribute__((address_space(3)))
typedef unsigned short bf16_t;
typedef short bf16x8 __attribute__((ext_vector_type(8)));
typedef float f32x4 __attribute__((ext_vector_type(4)));
typedef float f32x16 __attribute__((ext_vector_type(16)));
typedef unsigned u32x4 __attribute__((ext_vector_type(4)));
typedef unsigned u32x2 __attribute__((ext_vector_type(2)));

#ifndef PROBE_MASK
#define PROBE_MASK 0
#endif
#define REP(k) ((((PROBE_MASK) >> (k)) & 1) ? 2 : 1)
#ifndef MK_N_LAUNCHES
#define MK_N_LAUNCHES 1
#endif

constexpr int SEQ = 16384, CTX = 256, MT = SEQ + CTX, DM = 2048, FF = 5632, FF2 = 2 * FF, DIN = 6144, DA = 1024, NH = 16;
constexpr int NMOD = 9 * DM;
constexpr float EPS = 1e-6f, LOG2E = 1.4426950408889634f;
constexpr int KSPLIT = 32;

constexpr size_t MiB = 1u << 20;
constexpr size_t WS_MODS = 0;
constexpr size_t WS_ROPE = 256 * 1024;
constexpr size_t WS_MPART = 1 * MiB;
constexpr size_t WS_BAR = 512 * 1024;
constexpr size_t WS_SSQ = 6 * MiB;
constexpr size_t WS_WT1 = 8 * MiB, WS_WT2 = 52 * MiB, WS_WT3 = 74 * MiB, WS_WT4 = 98 * MiB, WS_WT5 = 106 * MiB, WS_WT6 = 150 * MiB;
constexpr size_t WS_H = 172 * MiB;
constexpr size_t WS_X1 = 237 * MiB;
constexpr size_t WS_G = 367 * MiB;
constexpr size_t WS_Q = 367 * MiB, WS_K = 399 * MiB, WS_VT = 432 * MiB, WS_BG = 465 * MiB, WS_Z = 497 * MiB;
constexpr size_t WS_END = 546 * MiB;

__device__ __forceinline__ unsigned cvt_pk_bf16(float lo, float hi) { unsigned r; asm("v_cvt_pk_bf16_f32 %0, %1, %2" : "=v"(r) : "v"(lo), "v"(hi)); return r; }
__device__ __forceinline__ float bf2f(unsigned short b) { return __builtin_bit_cast(float, (unsigned)b << 16); }
__device__ __forceinline__ float wave_sum(float v) {
#pragma unroll
    for (int o = 1; o < 64; o <<= 1) v += __shfl_xor(v, o);
    return v;
}
__device__ __forceinline__ float silu_f(float a) { return a * __builtin_amdgcn_rcpf(1.0f + __builtin_amdgcn_exp2f(-a * LOG2E)); }

namespace pg8 {
constexpr int BM = 256, BK = 64, HALF = 128, HTB = HALF * BK * 2, STAGE_BYTES = 8 * HTB, NXCD = 8, WGM = 8;
__host__ __device__ __forceinline__ int lds_byte(int r, int c) { const int st = (r >> 4) * 2 + (c >> 5), rr = r & 15, cc = c & 31, ob = rr * 64 + cc * 2; return st * 1024 + (ob ^ (((ob >> 9) & 1) << 5)); }
__host__ __device__ __forceinline__ void stage_rc(int b, int& R, int& C) { const int st = b / 1024, sb = b % 1024, swz = sb ^ (((sb >> 9) & 1) << 5); R = (st >> 1) * 16 + swz / 64; C = (st & 1) * 32 + (swz % 64) / 2; }
__host__ __device__ __forceinline__ int perm32(int rho) { const int n = rho >> 4, i = rho & 15; return 8 * (i >> 2) + 4 * n + (i & 3); }

struct Unit { int pm, pn, kind; const char* pa; const char* pb; };

template <class Epi, class Sched>
__device__ __forceinline__ void gemm_phase(LAS unsigned char* lds, const int K, const Sched& S, const Epi& E) {
    const int tid = threadIdx.x, wid = __builtin_amdgcn_readfirstlane(tid >> 6), lane = tid & 63, wr = wid >> 2, wc = wid & 3, fr = lane & 15, fq = lane >> 4;
    const int nt = K / BK;
    unsigned voffA[2], voffB[2];
#pragma unroll
    for (int i = 0; i < 2; ++i) { int R, C; stage_rc(tid * 16 + i * 8192, R, C); const int Rb = (R & ~31) + perm32(R & 31);
        voffA[i] = (unsigned)(R * K + C) * 2u; voffB[i] = (unsigned)(Rb * K + C) * 2u; }
    const size_t kstep = (size_t)(BK * 2);
    const size_t hstep = (size_t)HALF * K * 2;
    const unsigned ldsw = (unsigned)wid * 1024u;
    const int aoff = lds_byte(wr * 64 + fr, fq * 8), boff = lds_byte(wc * 32 + fr, fq * 8);
#define PG8_SA(b, h) (((b) * 2 + (h)) * HTB)
#define PG8_SB(b, h) ((4 + (b) * 2 + (h)) * HTB)
#define PG8_STAGE(bufoff, gbase, voff) do { _Pragma("unroll") for (int _i = 0; _i < 2; ++_i) \
        __builtin_amdgcn_global_load_lds((const unsigned*)((const char*)(gbase) + (voff)[_i]), (LAS unsigned*)(lds + (bufoff) + ldsw + _i * 8192), 16, 0, 0); } while (0)
#define PG8_LDA(dst, b, h) do { _Pragma("unroll") for (int m = 0; m < 4; ++m) _Pragma("unroll") for (int k = 0; k < 2; ++k) dst[m][k] = *(const LAS bf16x8*)(lds + PG8_SA(b, h) + aoff + m * 2048 + k * 1024); } while (0)
#define PG8_LDB(dst, b, h) do { _Pragma("unroll") for (int n = 0; n < 2; ++n) _Pragma("unroll") for (int k = 0; k < 2; ++k) dst[n][k] = *(const LAS bf16x8*)(lds + PG8_SB(b, h) + boff + n * 2048 + k * 1024); } while (0)
#define PG8_MMA(ai, bj, At, Bt) do { __builtin_amdgcn_s_setprio(1); _Pragma("unroll") for (int m = 0; m < 4; ++m) _Pragma("unroll") for (int n = 0; n < 2; ++n) _Pragma("unroll") for (int k = 0; k < 2; ++k) \
        acc[ai][bj][m][n] = __builtin_amdgcn_mfma_f32_16x16x32_bf16(Bt[n][k], At[m][k], acc[ai][bj][m][n], 0, 0, 0); __builtin_amdgcn_s_setprio(0); } while (0)
#define PG8_WAIT_V(n) asm volatile("s_waitcnt vmcnt(" #n ")" ::: "memory")
#define PG8_WAIT_L(n) asm volatile("s_waitcnt lgkmcnt(" #n ")" ::: "memory")
#define PG8_BAR __builtin_amdgcn_s_barrier()
#define PG8_SCHED __builtin_amdgcn_sched_barrier(0)
    Unit cur, nxt; int ui = 0;
    if (!S.next(0, cur)) return;
    f32x4 acc[2][2][4][2];
#pragma unroll
    for (int a = 0; a < 2; ++a)
#pragma unroll
        for (int b = 0; b < 2; ++b)
#pragma unroll
            for (int m = 0; m < 4; ++m)
#pragma unroll
                for (int n = 0; n < 2; ++n) acc[a][b][m][n] = (f32x4){0.f, 0.f, 0.f, 0.f};
    bf16x8 At[4][2], B0[2][2], B1[2][2];
    const char* cA = cur.pa; const char* cB = cur.pb;
    PG8_STAGE(PG8_SB(0, 0), cB, voffB); PG8_STAGE(PG8_SB(0, 1), cB + hstep, voffB); PG8_STAGE(PG8_SA(0, 0), cA, voffA); PG8_STAGE(PG8_SA(0, 1), cA + hstep, voffA);
    if (wr == 1) PG8_BAR;
    PG8_WAIT_V(2); PG8_BAR;
    PG8_STAGE(PG8_SB(1, 0), cB + kstep, voffB); PG8_STAGE(PG8_SA(1, 0), cA + kstep, voffA); PG8_STAGE(PG8_SB(1, 1), cB + hstep + kstep, voffB);
    PG8_WAIT_V(6); PG8_BAR;
    for (;;) {
        const bool has_next = S.next(ui + 1, nxt);
        const char* nA = has_next ? nxt.pa : cA; const char* nB = has_next ? nxt.pb : cB;
        for (int t = 0; t < nt; t += 2) {
            const bool last = (t == nt - 2);
            const char* a1 = cA + (size_t)(t + 1) * kstep;
            const char* a2 = last ? nA : cA + (size_t)(t + 2) * kstep; const char* b2 = last ? nB : cB + (size_t)(t + 2) * kstep;
            const char* a3 = a2 + kstep; const char* b3 = b2 + kstep;
            PG8_LDB(B0, 0, 0); PG8_LDB(B1, 0, 1); PG8_SCHED; PG8_LDA(At, 0, 0); PG8_STAGE(PG8_SA(1, 1), a1 + hstep, voffA);
            PG8_WAIT_V(8); PG8_WAIT_L(0); PG8_BAR; PG8_MMA(0, 0, At, B0); PG8_MMA(0, 1, At, B1); PG8_BAR; PG8_SCHED;
            PG8_LDA(At, 0, 1); PG8_STAGE(PG8_SB(0, 0), b2, voffB); PG8_STAGE(PG8_SB(0, 1), b2 + hstep, voffB); PG8_STAGE(PG8_SA(0, 0), a2, voffA);
            PG8_WAIT_V(8); PG8_WAIT_L(0); PG8_BAR; PG8_MMA(1, 0, At, B0); PG8_MMA(1, 1, At, B1); PG8_BAR; PG8_SCHED;
            PG8_LDB(B0, 1, 0); PG8_LDB(B1, 1, 1); PG8_SCHED; PG8_LDA(At, 1, 0); PG8_STAGE(PG8_SA(0, 1), a2 + hstep, voffA);
            PG8_WAIT_V(8); PG8_WAIT_L(0); PG8_BAR; PG8_MMA(0, 0, At, B0); PG8_MMA(0, 1, At, B1); PG8_BAR; PG8_SCHED;
            PG8_LDA(At, 1, 1); PG8_STAGE(PG8_SB(1, 0), b3, voffB); PG8_STAGE(PG8_SB(1, 1), b3 + hstep, voffB); PG8_STAGE(PG8_SA(1, 0), a3, voffA);
            PG8_WAIT_V(8); PG8_WAIT_L(0); PG8_BAR; PG8_MMA(1, 0, At, B0); PG8_MMA(1, 1, At, B1); PG8_BAR; PG8_SCHED;
        }
        if (wr == 0) PG8_BAR;
        E(acc, cur, wr, wc, fr, fq);
        if (!has_next) break;
#pragma unroll
        for (int a = 0; a < 2; ++a)
#pragma unroll
            for (int b = 0; b < 2; ++b)
#pragma unroll
                for (int m = 0; m < 4; ++m)
#pragma unroll
                    for (int n = 0; n < 2; ++n) acc[a][b][m][n] = (f32x4){0.f, 0.f, 0.f, 0.f};
        cur = nxt; cA = nA; cB = nB; ++ui;
        if (wr == 1) PG8_BAR;
    }
    PG8_WAIT_V(0);
    PG8_BAR;
#undef PG8_SA
#undef PG8_SB
#undef PG8_STAGE
#undef PG8_LDA
#undef PG8_LDB
#undef PG8_MMA
#undef PG8_WAIT_V
#undef PG8_WAIT_L
#undef PG8_BAR
#undef PG8_SCHED
}
}

enum { KQ = 0, KK = 1, KKCTX = 2, KBG = 3, KZ = 4, KVT = 5 };
struct GSched {
    const char* A; const char* B; int K, nM, nN, nX, mode, G, c;
    __device__ __forceinline__ bool next(int i, pg8::Unit& u) const {
        const int nwg = nM * nN; const long L = (long)i * G + c; if (L >= nwg + nX) return false;
        const size_t tstep = (size_t)256 * K * 2;
        if (L < nwg) {
            int wgid = (int)L; { const int q = nwg / pg8::NXCD, r = nwg % pg8::NXCD, xcd = wgid % pg8::NXCD, off = wgid / pg8::NXCD; wgid = (xcd < r ? xcd * (q + 1) : r * (q + 1) + (xcd - r) * q) + off; }
            const int nig = pg8::WGM * nN, gid = wgid / nig, fm = gid * pg8::WGM, gsz = (nM - fm) < pg8::WGM ? (nM - fm) : pg8::WGM;
            const int pm = fm + ((wgid % nig) % gsz), pi = (wgid % nig) / gsz;
            int pnB = pi, kind = 0;
            if (mode == 3) { pnB = pi < 8 ? pi : pi + 4; kind = pi < 4 ? KQ : pi < 8 ? KK : pi < 12 ? KBG : KZ; }
            u.pm = pm; u.pn = pnB; u.kind = kind; u.pa = A + (size_t)pm * tstep; u.pb = B + (size_t)pnB * tstep;
        } else {
            const int x = (int)(L - nwg);
            if (mode != 3) { u.pm = nM; u.pn = x; u.kind = 0; u.pa = A + (size_t)nM * tstep; u.pb = B + (size_t)x * tstep; }
            else { const int pmv = x >> 6, pnv = x & 63; u.pm = pmv; u.pn = pnv; u.kind = KVT; u.pa = B + (size_t)(8 + pmv) * tstep; u.pb = A + (size_t)pnv * tstep; }
        }
        return true;
    }
};

typedef f32x4 Acc[2][2][4][2];
struct EpiSwiGLU {
    bf16_t* G;
    __device__ __forceinline__ void operator()(const Acc& acc, const pg8::Unit& u, int wr, int wc, int fr, int fq) const {
        const int row0 = u.pm * 256 + wr * 64 + fr, col0 = u.pn * 128 + wc * 32 + 8 * fq;
#pragma unroll
        for (int ai = 0; ai < 2; ++ai)
#pragma unroll
            for (int m = 0; m < 4; ++m) {
                bf16_t* p = G + (size_t)(row0 + ai * 128 + m * 16) * FF + col0;
                const f32x4 a0 = acc[ai][0][m][0], a1 = acc[ai][0][m][1], b0 = acc[ai][1][m][0], b1 = acc[ai][1][m][1];
                u32x4 w;
                w.x = cvt_pk_bf16(silu_f(a0[0]) * b0[0], silu_f(a0[1]) * b0[1]); w.y = cvt_pk_bf16(silu_f(a0[2]) * b0[2], silu_f(a0[3]) * b0[3]);
                w.z = cvt_pk_bf16(silu_f(a1[0]) * b1[0], silu_f(a1[1]) * b1[1]); w.w = cvt_pk_bf16(silu_f(a1[2]) * b1[2], silu_f(a1[3]) * b1[3]);
                *(u32x4*)p = w;
            }
    }
};
struct EpiResid {
    const float* base_x; const float* base_c; float* out; const float* gate_x; const float* gate_c; float s;
    __device__ __forceinline__ void operator()(const Acc& acc, const pg8::Unit& u, int wr, int wc, int fr, int fq) const {
        const bool isc = u.pm >= 64;
        const float* base = isc ? base_c - (size_t)SEQ * DM : base_x; const float* gate = isc ? gate_c : gate_x;
        const int row0 = u.pm * 256 + wr * 64 + fr, col0 = u.pn * 256 + wc * 32 + 8 * fq;
        f32x4 gv[2][2];
#pragma unroll
        for (int bj = 0; bj < 2; ++bj)
#pragma unroll
            for (int n = 0; n < 2; ++n) gv[bj][n] = *(const f32x4*)(gate + col0 + bj * 128 + 4 * n) * s;
#pragma unroll
        for (int ai = 0; ai < 2; ++ai)
#pragma unroll
            for (int m = 0; m < 4; ++m) {
                const size_t off = (size_t)(row0 + ai * 128 + m * 16) * DM + col0;
#pragma unroll
                for (int bj = 0; bj < 2; ++bj)
#pragma unroll
                    for (int n = 0; n < 2; ++n) {
                        const f32x4 b = *(const f32x4*)(base + off + bj * 128 + 4 * n);
                        *(f32x4*)(out + off + bj * 128 + 4 * n) = b + gv[bj][n] * acc[ai][bj][m][n];
                    }
            }
    }
};
struct EpiInProj {
    bf16_t *Q, *Kb, *Vt, *BG, *Z; const float *qn, *kn, *rc, *rs;
    template <bool ROPE> __device__ __forceinline__ void qk(const Acc& acc, int row0, bf16_t* dst, int head, const float* gain, float oscale, int fq) const {
        f32x4 g[2][2];
#pragma unroll
        for (int bj = 0; bj < 2; ++bj)
#pragma unroll
            for (int n = 0; n < 2; ++n) g[bj][n] = *(const f32x4*)(gain + 32 * bj + 16 * n + 4 * fq);
#pragma unroll
        for (int ai = 0; ai < 2; ++ai)
#pragma unroll
            for (int m = 0; m < 4; ++m) {
                const int r = row0 + ai * 128 + m * 16;
                float ss = 0.f;
#pragma unroll
                for (int bj = 0; bj < 2; ++bj)
#pragma unroll
                    for (int n = 0; n < 2; ++n) { const f32x4 v = acc[ai][bj][m][n]; ss += (v[0] * v[0] + v[1] * v[1]) + (v[2] * v[2] + v[3] * v[3]); }
                ss += __shfl_xor(ss, 16); ss += __shfl_xor(ss, 32);
                const float rinv = __builtin_amdgcn_rsqf(ss * (1.0f / 64.0f) + EPS) * oscale;
                bf16_t* p = dst + (size_t)r * DA + head * 64 + 4 * fq;
#pragma unroll
                for (int bj = 0; bj < 2; ++bj) {
                    const f32x4 y0 = acc[ai][bj][m][0] * rinv * g[bj][0], y1 = acc[ai][bj][m][1] * rinv * g[bj][1];
                    f32x4 o1, o2;
                    if (ROPE) { const int pos = bj ? (r & 63) : (r >> 6);
                        const f32x4 C = *(const f32x4*)(rc + pos * 16 + 4 * fq), Sn = *(const f32x4*)(rs + pos * 16 + 4 * fq);
                        o1 = y0 * C - y1 * Sn; o2 = y0 * Sn + y1 * C; }
                    else { o1 = y0; o2 = y1; }
                    u32x2 w1, w2; w1.x = cvt_pk_bf16(o1[0], o1[1]); w1.y = cvt_pk_bf16(o1[2], o1[3]); w2.x = cvt_pk_bf16(o2[0], o2[1]); w2.y = cvt_pk_bf16(o2[2], o2[3]);
                    *(u32x2*)(p + 32 * bj) = w1; *(u32x2*)(p + 32 * bj + 16) = w2;
                }
            }
    }
    __device__ __forceinline__ void operator()(const Acc& acc, const pg8::Unit& u, int wr, int wc, int fr, int fq) const {
        const int row0 = u.pm * 256 + wr * 64 + fr;
        if (u.kind == KQ) { qk<true>(acc, row0, Q, 4 * u.pn + wc, qn, 0.125f * LOG2E, fq); }
        else if (u.kind == KK) { qk<true>(acc, row0, Kb, 4 * (u.pn - 4) + wc, kn, 1.0f, fq); }
        else if (u.kind == KKCTX) { qk<false>(acc, row0, Kb, 4 * (u.pn - 4) + wc, kn, 1.0f, fq); }
        else if (u.kind == KZ) {
            const int col0 = (u.pn - 16) * 128 + wc * 32 + 8 * fq;
#pragma unroll
            for (int ai = 0; ai < 2; ++ai)
#pragma unroll
                for (int m = 0; m < 4; ++m) {
                    const f32x4 z0 = acc[ai][0][m][0] * acc[ai][1][m][0], z1 = acc[ai][0][m][1] * acc[ai][1][m][1];
                    u32x4 w; w.x = cvt_pk_bf16(z0[0], z0[1]); w.y = cvt_pk_bf16(z0[2], z0[3]); w.z = cvt_pk_bf16(z1[0], z1[1]); w.w = cvt_pk_bf16(z1[2], z1[3]);
                    *(u32x4*)(Z + (size_t)(row0 + ai * 128 + m * 16) * DA + col0) = w;
                }
        } else {
            bf16_t* dst; size_t ld; int col0;
            if (u.kind == KBG) { dst = BG; ld = DA; col0 = (u.pn - 12) * 256 + wc * 32 + 8 * fq; }
            else { dst = Vt; ld = MT; col0 = u.pn * 256 + wc * 32 + 8 * fq; }
#pragma unroll
            for (int ai = 0; ai < 2; ++ai)
#pragma unroll
                for (int m = 0; m < 4; ++m)
#pragma unroll
                    for (int bj = 0; bj < 2; ++bj) {
                        const f32x4 v0 = acc[ai][bj][m][0], v1 = acc[ai][bj][m][1];
                        u32x4 w; w.x = cvt_pk_bf16(v0[0], v0[1]); w.y = cvt_pk_bf16(v0[2], v0[3]); w.z = cvt_pk_bf16(v1[0], v1[1]); w.w = cvt_pk_bf16(v1[2], v1[3]);
                        *(u32x4*)(dst + (size_t)(row0 + ai * 128 + m * 16) * ld + col0 + bj * 128) = w;
                    }
        }
    }
};

__device__ __forceinline__ int colmap(int mode, int np) {
    if (mode == 1) { const int tile = np >> 8, w = np & 255; return (w >> 7) * FF + tile * 128 + (w & 127); }
    if (mode == 3) {
        if (np < 2048) { const int base = np & ~1023, rel = np & 1023, tile = rel >> 8, w = rel & 255;
            const int bj = w >> 7, wc = (w >> 5) & 3, fq = (w >> 3) & 3, n = (w >> 2) & 1, e = w & 3;
            return base + 64 * (4 * tile + wc) + 32 * bj + 16 * n + 4 * fq + e; }
        if (np < 4096) return np;
        const int rel = np - 4096, tile = rel >> 8, w = rel & 255; return ((w >> 7) ? 5120 : 4096) + tile * 128 + (w & 127);
    }
    return np;
}
__device__ __forceinline__ void transpose_item(const float* W, int K, int N, bf16_t* Wt, int mode, int item, int lane) {
    const int nblk = N / 32, kb = item / nblk, nb = item % nblk;
    const int ns = lane & 7, kg = lane >> 3, np0 = nb * 32 + 4 * ns, c0 = colmap(mode, np0), k0 = kb * 64 + 8 * kg;
    f32x4 v[8];
#pragma unroll
    for (int j = 0; j < 8; ++j) v[j] = *(const f32x4*)(W + (size_t)(k0 + j) * N + c0);
#pragma unroll
    for (int e = 0; e < 4; ++e) { u32x4 w; w.x = cvt_pk_bf16(v[0][e], v[1][e]); w.y = cvt_pk_bf16(v[2][e], v[3][e]); w.z = cvt_pk_bf16(v[4][e], v[5][e]); w.w = cvt_pk_bf16(v[6][e], v[7][e]);
        *(u32x4*)(Wt + (size_t)(np0 + e) * K + k0) = w; }
}
__device__ __forceinline__ void ada_item(const float* wada, const float* cvec, const float* cctx, float* part, int item, int lane) {
    const int ks = item / 72, cc = item % 72;
    const float sx = silu_f(cvec[ks * 64 + lane]), sc = silu_f(cctx[ks * 64 + lane]);
    f32x4 ax = {0.f, 0.f, 0.f, 0.f}, ac = {0.f, 0.f, 0.f, 0.f};
    const float* wp = wada + (size_t)(ks * 64) * NMOD + cc * 256 + 4 * lane;
#pragma unroll 16
    for (int k = 0; k < 64; ++k) { const f32x4 w = *(const f32x4*)(wp + (size_t)k * NMOD);
        const float a = __builtin_bit_cast(float, __builtin_amdgcn_readlane(__builtin_bit_cast(int, sx), k)), b = __builtin_bit_cast(float, __builtin_amdgcn_readlane(__builtin_bit_cast(int, sc), k));
        ax += w * a; ac += w * b; }
    *(f32x4*)(part + (size_t)(ks * 2 + 0) * NMOD + cc * 256 + 4 * lane) = ax;
    *(f32x4*)(part + (size_t)(ks * 2 + 1) * NMOD + cc * 256 + 4 * lane) = ac;
}
__device__ __forceinline__ void norm_rows(const float* src_x, const float* src_c, int nrows, bf16_t* H, const float* g, const float* mods, int ishift, int iscale, int gw, int ngw, int lane) {
    for (int m = gw; m < nrows; m += ngw) {
        const bool isc = m >= SEQ;
        const float* src = isc ? src_c + (size_t)(m - SEQ) * DM : src_x + (size_t)m * DM; const float* md = mods + (isc ? NMOD : 0);
        f32x4 v[8]; float ss = 0.f;
#pragma unroll
        for (int j = 0; j < 8; ++j) { v[j] = *(const f32x4*)(src + 4 * lane + 256 * j); ss += (v[j][0] * v[j][0] + v[j][1] * v[j][1]) + (v[j][2] * v[j][2] + v[j][3] * v[j][3]); }
        const float rinv = __builtin_amdgcn_rsqf(wave_sum(ss) * (1.0f / DM) + EPS);
#pragma unroll
        for (int j = 0; j < 8; ++j) { const int c = 4 * lane + 256 * j;
            const f32x4 gg = *(const f32x4*)(g + c), sc = *(const f32x4*)(md + iscale * DM + c), sh = *(const f32x4*)(md + ishift * DM + c);
            const f32x4 h = v[j] * rinv * gg * (sc + 1.0f) + sh;
            u32x2 w; w.x = cvt_pk_bf16(h[0], h[1]); w.y = cvt_pk_bf16(h[2], h[3]);
            *(u32x2*)(H + (size_t)m * DM + c) = w; }
    }
}

__device__ __forceinline__ void attn_unit(int u, const bf16_t* Q, const bf16_t* Kb, const bf16_t* Vt, const float* rpb, bf16_t* Y, float* ssq, LAS float* tab, int lane) {
    const int h = u >> 9, tile = u & 511, rp = tile >> 2, cg = tile & 3;
    const int ql = lane & 31, hi = lane >> 5;
    const int r0 = 2 * rp, qr = r0 + (ql >> 4), qc = 16 * cg + (ql & 15), qtok = qr * 64 + qc;
    for (int i = lane; i < 465; i += 64) tab[64 + i] = rpb[h * 465 + i] * LOG2E;
    bf16x8 qf[4];
#pragma unroll
    for (int c = 0; c < 4; ++c) qf[c] = *(const bf16x8*)(Q + (size_t)qtok * DA + h * 64 + 16 * c + 8 * hi);
    const int rs_q = min(max(qr - 4, 0), 248), cs_q = min(max(qc - 8, 0), 48);
    const int rs0 = min(max(r0 - 4, 0), 248), rs1 = min(max(r0 - 3, 0), 248);
    const int nblk = 8 + ((rs1 != rs0) ? 9 : 8);
    const int kc0 = min(max(16 * cg - 8, 0), 32);
    const int kap = (ql & 19) | ((ql & 4) << 1) | ((ql & 8) >> 1);
    const bf16_t* kbase = Kb + (size_t)kap * DA + h * 64 + 8 * hi;
    const bf16_t* vbase = Vt + (size_t)(h * 64 + ql) * MT + 8 * hi;
    f32x16 o0, o1;
#pragma unroll
    for (int i = 0; i < 16; ++i) { o0[i] = 0.f; o1[i] = 0.f; }
    float mrun = -1e30f, lrun = 0.f;
    asm volatile("s_waitcnt lgkmcnt(0)" ::: "memory");
    bf16x8 kf[4], vf[4], kn[4], vn[4];
    { const int tok0 = SEQ;
#pragma unroll
      for (int c = 0; c < 4; ++c) kn[c] = *(const bf16x8*)(kbase + (size_t)tok0 * DA + 16 * c);
#pragma unroll
      for (int d = 0; d < 2; ++d)
#pragma unroll
          for (int t = 0; t < 2; ++t) vn[d * 2 + t] = *(const bf16x8*)(vbase + (size_t)(32 * d) * MT + tok0 + 16 * t); }
    for (int b = 0; b < nblk; ++b) {
#pragma unroll
        for (int c = 0; c < 4; ++c) { kf[c] = kn[c]; vf[c] = vn[c]; }
        if (b + 1 < nblk) { const int bn = b + 1; const int tok0 = bn < 8 ? SEQ + 32 * bn : (rs0 + bn - 8) * 64 + kc0;
#pragma unroll
            for (int c = 0; c < 4; ++c) kn[c] = *(const bf16x8*)(kbase + (size_t)tok0 * DA + 16 * c);
#pragma unroll
            for (int d = 0; d < 2; ++d)
#pragma unroll
                for (int t = 0; t < 2; ++t) vn[d * 2 + t] = *(const bf16x8*)(vbase + (size_t)(32 * d) * MT + tok0 + 16 * t); }
        f32x16 s;
#pragma unroll
        for (int i = 0; i < 16; ++i) s[i] = 0.f;
#pragma unroll
        for (int c = 0; c < 4; ++c) s = __builtin_amdgcn_mfma_f32_32x32x16_bf16(kf[c], qf[c], s, 0, 0, 0);
        if (b >= 8) {
            const int kr = rs0 + b - 8;
            const bool row_ok = (kr >= rs_q) && (kr < rs_q + 8);
            const int lo = cs_q - kc0 - 8 * hi;
            const int bi = 64 + (kr - qr + 7) * 31 + (kc0 + 8 * hi - qc + 15);
#pragma unroll
            for (int i = 0; i < 16; ++i) { const int j = 16 * (i >> 3) + 4 * ((i >> 2) & 1) + (i & 3);
                const bool ok = row_ok && (j >= lo) && (j < lo + 16);
                const float bias = tab[bi + j];
                s[i] = ok ? s[i] + bias : -1e30f; }
        }
        float bm = s[0];
#pragma unroll
        for (int i = 1; i < 16; ++i) bm = fmaxf(bm, s[i]);
        bm = fmaxf(bm, __shfl_xor(bm, 32));
        const float mnew = fmaxf(mrun, bm), alpha = __builtin_amdgcn_exp2f(mrun - mnew);
        mrun = mnew;
        float ps = 0.f;
#pragma unroll
        for (int i = 0; i < 16; ++i) { s[i] = __builtin_amdgcn_exp2f(s[i] - mnew); ps += s[i]; }
        lrun = lrun * alpha + ps;
#pragma unroll
        for (int i = 0; i < 16; ++i) { o0[i] *= alpha; o1[i] *= alpha; }
        u32x4 p0, p1;
        p0.x = cvt_pk_bf16(s[0], s[1]); p0.y = cvt_pk_bf16(s[2], s[3]); p0.z = cvt_pk_bf16(s[4], s[5]); p0.w = cvt_pk_bf16(s[6], s[7]);
        p1.x = cvt_pk_bf16(s[8], s[9]); p1.y = cvt_pk_bf16(s[10], s[11]); p1.z = cvt_pk_bf16(s[12], s[13]); p1.w = cvt_pk_bf16(s[14], s[15]);
        const bf16x8 pb0 = __builtin_bit_cast(bf16x8, p0), pb1 = __builtin_bit_cast(bf16x8, p1);
        o0 = __builtin_amdgcn_mfma_f32_32x32x16_bf16(vf[0], pb0, o0, 0, 0, 0);
        o0 = __builtin_amdgcn_mfma_f32_32x32x16_bf16(vf[1], pb1, o0, 0, 0, 0);
        o1 = __builtin_amdgcn_mfma_f32_32x32x16_bf16(vf[2], pb0, o1, 0, 0, 0);
        o1 = __builtin_amdgcn_mfma_f32_32x32x16_bf16(vf[3], pb1, o1, 0, 0, 0);
    }
    const float ltot = lrun + __shfl_xor(lrun, 32), inv = 1.0f / ltot;
    float sq = 0.f;
    bf16_t* yp = Y + (size_t)qtok * DM + h * 64 + 4 * hi;
#pragma unroll
    for (int a = 0; a < 4; ++a) {
        const float x0 = o0[4 * a] * inv, x1 = o0[4 * a + 1] * inv, x2 = o0[4 * a + 2] * inv, x3 = o0[4 * a + 3] * inv;
        const float y0 = o1[4 * a] * inv, y1 = o1[4 * a + 1] * inv, y2 = o1[4 * a + 2] * inv, y3 = o1[4 * a + 3] * inv;
        sq += (x0 * x0 + x1 * x1) + (x2 * x2 + x3 * x3) + (y0 * y0 + y1 * y1) + (y2 * y2 + y3 * y3);
        u32x2 w0, w1; w0.x = cvt_pk_bf16(x0, x1); w0.y = cvt_pk_bf16(x2, x3); w1.x = cvt_pk_bf16(y0, y1); w1.y = cvt_pk_bf16(y2, y3);
        *(u32x2*)(yp + 8 * a) = w0; *(u32x2*)(yp + 32 + 8 * a) = w1;
    }
    sq += __shfl_xor(sq, 32);
    if (hi == 0) ssq[h * SEQ + qtok] = sq;
}

__device__ __forceinline__ void conv_rows(const bf16_t* BG, const bf16_t* Z, const float* cw, const float* cb, const float* gc, bf16_t* Y, int gw, int ngw, int lane) {
    for (int t = gw; t < SEQ; t += ngw) {
        float val[16]; float ss = 0.f;
#pragma unroll
        for (int hf = 0; hf < 2; ++hf) {
            const int ch = 512 * hf + 8 * lane;
            const bf16x8 bg = *(const bf16x8*)(BG + (size_t)t * DA + ch), z1 = *(const bf16x8*)(Z + (size_t)t * DA + ch);
            bf16x8 z0 = {0, 0, 0, 0, 0, 0, 0, 0}, z2 = {0, 0, 0, 0, 0, 0, 0, 0};
            if (t > 0) z0 = *(const bf16x8*)(Z + (size_t)(t - 1) * DA + ch);
            if (t < SEQ - 1) z2 = *(const bf16x8*)(Z + (size_t)(t + 1) * DA + ch);
#pragma unroll
            for (int q4 = 0; q4 < 2; ++q4) {
                const f32x4 w0 = *(const f32x4*)(cw + ch + 4 * q4), w1 = *(const f32x4*)(cw + DA + ch + 4 * q4), w2 = *(const f32x4*)(cw + 2 * DA + ch + 4 * q4), bb = *(const f32x4*)(cb + ch + 4 * q4);
#pragma unroll
                for (int e = 0; e < 4; ++e) { const int i = 4 * q4 + e;
                    const float y = bb[e] + w0[e] * bf2f((unsigned short)z0[i]) + w1[e] * bf2f((unsigned short)z1[i]) + w2[e] * bf2f((unsigned short)z2[i]);
                    const float cv = bf2f((unsigned short)bg[i]) * y; val[8 * hf + i] = cv; ss += cv * cv; }
            }
        }
        const float rinv = __builtin_amdgcn_rsqf(wave_sum(ss) * (1.0f / DA) + EPS);
#pragma unroll
        for (int hf = 0; hf < 2; ++hf) {
            const int ch = 512 * hf + 8 * lane;
            const f32x4 g0 = *(const f32x4*)(gc + ch), g1 = *(const f32x4*)(gc + ch + 4);
            u32x4 w; w.x = cvt_pk_bf16(val[8 * hf + 0] * rinv * g0[0], val[8 * hf + 1] * rinv * g0[1]); w.y = cvt_pk_bf16(val[8 * hf + 2] * rinv * g0[2], val[8 * hf + 3] * rinv * g0[3]);
            w.z = cvt_pk_bf16(val[8 * hf + 4] * rinv * g1[0], val[8 * hf + 5] * rinv * g1[1]); w.w = cvt_pk_bf16(val[8 * hf + 6] * rinv * g1[2], val[8 * hf + 7] * rinv * g1[3]);
            *(u32x4*)(Y + (size_t)t * DM + DA + ch) = w;
        }
    }
}
__device__ __forceinline__ void ynorm_rows(bf16_t* Y, const float* ssq, const float* ga, int gw, int ngw, int lane) {
    for (int t = gw; t < SEQ; t += ngw) {
        const float part = lane < NH ? ssq[lane * SEQ + t] : 0.f;
        const float rinv = __builtin_amdgcn_rsqf(wave_sum(part) * (1.0f / DA) + EPS);
#pragma unroll
        for (int hf = 0; hf < 2; ++hf) {
            const int ch = 512 * hf + 8 * lane;
            const bf16x8 a = *(const bf16x8*)(Y + (size_t)t * DM + ch);
            const f32x4 g0 = *(const f32x4*)(ga + ch), g1 = *(const f32x4*)(ga + ch + 4);
            u32x4 w; w.x = cvt_pk_bf16(bf2f((unsigned short)a[0]) * rinv * g0[0], bf2f((unsigned short)a[1]) * rinv * g0[1]); w.y = cvt_pk_bf16(bf2f((unsigned short)a[2]) * rinv * g0[2], bf2f((unsigned short)a[3]) * rinv * g0[3]);
            w.z = cvt_pk_bf16(bf2f((unsigned short)a[4]) * rinv * g1[0], bf2f((unsigned short)a[5]) * rinv * g1[1]); w.w = cvt_pk_bf16(bf2f((unsigned short)a[6]) * rinv * g1[2], bf2f((unsigned short)a[7]) * rinv * g1[3]);
            *(u32x4*)(Y + (size_t)t * DM + ch) = w;
        }
    }
}


template <class Fin>
__device__ __forceinline__ void wg_gemm64(const bf16_t* act, const bf16_t* w0, const bf16_t* w1, const int K, LAS unsigned char* lds, int wave, int lane, const Fin& fin) {
    const int ql = lane & 31, hi = lane >> 5;
    const int kw = K >> 3;
    unsigned voff[2];
    const int r16 = lane >> 2, g4 = lane & 3;
#pragma unroll
    for (int i = 0; i < 2; ++i) voff[i] = (unsigned)((16 * i + r16) * K + 8 * g4) * 2u;
    const char* gp0 = (const char*)(act + wave * kw); const char* gp1 = (const char*)(act + (size_t)32 * K + wave * kw); const char* gp2 = (const char*)(w0 + wave * kw); const char* gp3 = (const char*)(w1 + wave * kw);
    LAS unsigned char* wl = lds + wave * 16384;
    const int woff = r16 * 64 + ((g4 ^ ((r16 >> 1) & 3)) << 4);
    const int roff = ql * 64;
    f32x16 acc[2][2];
#pragma unroll
    for (int cb = 0; cb < 2; ++cb)
#pragma unroll
        for (int rb = 0; rb < 2; ++rb)
#pragma unroll
            for (int i = 0; i < 16; ++i) acc[cb][rb][i] = 0.f;
    bf16x8 st[4][2];
#pragma unroll
    for (int i = 0; i < 2; ++i) { st[0][i] = *(const bf16x8*)(gp0 + voff[i]); st[1][i] = *(const bf16x8*)(gp1 + voff[i]); st[2][i] = *(const bf16x8*)(gp2 + voff[i]); st[3][i] = *(const bf16x8*)(gp3 + voff[i]); }
    for (int k = 0; k < kw; k += 32) {
#pragma unroll
        for (int b4 = 0; b4 < 4; ++b4)
#pragma unroll
            for (int i = 0; i < 2; ++i) *(LAS bf16x8*)(wl + (b4 * 32 + 16 * i) * 64 + woff) = st[b4][i];
        asm volatile("" ::: "memory");
        if (k + 32 < kw) {
#pragma unroll
            for (int i = 0; i < 2; ++i) { const size_t ko = (size_t)(k + 32) * 2; st[0][i] = *(const bf16x8*)(gp0 + ko + voff[i]); st[1][i] = *(const bf16x8*)(gp1 + ko + voff[i]); st[2][i] = *(const bf16x8*)(gp2 + ko + voff[i]); st[3][i] = *(const bf16x8*)(gp3 + ko + voff[i]); }
        }
#pragma unroll
        for (int sub = 0; sub < 2; ++sub) {
            const int go = ((2 * sub + hi) ^ ((ql >> 1) & 3)) << 4;
            const bf16x8 a0 = *(const LAS bf16x8*)(wl + roff + go), a1 = *(const LAS bf16x8*)(wl + 2048 + roff + go), b0 = *(const LAS bf16x8*)(wl + 4096 + roff + go), b1 = *(const LAS bf16x8*)(wl + 6144 + roff + go);
            acc[0][0] = __builtin_amdgcn_mfma_f32_32x32x16_bf16(b0, a0, acc[0][0], 0, 0, 0);
            acc[0][1] = __builtin_amdgcn_mfma_f32_32x32x16_bf16(b0, a1, acc[0][1], 0, 0, 0);
            acc[1][0] = __builtin_amdgcn_mfma_f32_32x32x16_bf16(b1, a0, acc[1][0], 0, 0, 0);
            acc[1][1] = __builtin_amdgcn_mfma_f32_32x32x16_bf16(b1, a1, acc[1][1], 0, 0, 0);
        }
        asm volatile("" ::: "memory");
    }
#pragma unroll
    for (int cb = 0; cb < 2; ++cb)
#pragma unroll
        for (int rb = 0; rb < 2; ++rb)
#pragma unroll
            for (int ig = 0; ig < 4; ++ig) { const int row = 32 * rb + ql, g = 8 * cb + 2 * ig + hi;
                *(LAS f32x4*)(lds + (((wave * 64 + row) * 16 + (g ^ (row & 15))) << 4)) = (f32x4){acc[cb][rb][4 * ig], acc[cb][rb][4 * ig + 1], acc[cb][rb][4 * ig + 2], acc[cb][rb][4 * ig + 3]}; }
    __syncthreads();
    const int c = ql, hh = hi;
#pragma unroll
    for (int j = 0; j < 4; ++j) { const int r = wave * 8 + hh * 4 + j;
        float va = 0.f, vb = 0.f;
#pragma unroll
        for (int w = 0; w < 8; ++w) {
            va += *(const LAS float*)(lds + ((((w * 64 + r) * 16 + ((c >> 2) ^ (r & 15))) << 4) + ((c & 3) << 2)));
            vb += *(const LAS float*)(lds + ((((w * 64 + r) * 16 + ((8 + (c >> 2)) ^ (r & 15))) << 4) + ((c & 3) << 2))); }
        fin(r, c, va, vb); }
    __syncthreads();
}

#define XB_TMO      128
#define XB_XCNT(j)  (256  + 64 * (j))
#define XB_XSUB(j)  (1280 + 64 * (j))
#define XB_XGEN(j)  (2304 + 64 * (j))
#define XB_TOP      3328
#define XB_TOPGEN   3392
#define XCD_BAR_WORDS 3456
#define XB_SPIN_CAP (1u << 18)
__device__ __forceinline__ unsigned xb_ld(unsigned* p)              { return __hip_atomic_load(p, __ATOMIC_RELAXED, __HIP_MEMORY_SCOPE_AGENT); }
__device__ __forceinline__ unsigned xb_add(unsigned* p, unsigned v) { return __hip_atomic_fetch_add(p, v, __ATOMIC_RELAXED, __HIP_MEMORY_SCOPE_AGENT); }
__device__ __forceinline__ unsigned xb_xcc_id() { return (unsigned)__builtin_amdgcn_s_getreg((3 << 11) | 20) & 0xFu; }
#define XB_SPIN(cond, bar) do { unsigned _sp = 0; while (cond) { __builtin_amdgcn_s_sleep(1); \
    if ((++_sp & 255u) == 0u) { if (xb_ld(&(bar)[XB_TMO])) break; if (_sp > XB_SPIN_CAP) { atomicAdd(&(bar)[XB_TMO], 1u); break; } } } } while (0)
struct XcdBarrier { unsigned* bar; unsigned x; volatile LAS unsigned* st; };
__device__ __forceinline__ XcdBarrier xcd_barrier_post(unsigned* bar, volatile LAS unsigned* st) {
    XcdBarrier b; b.bar = bar; b.x = xb_xcc_id(); b.st = st;
    if (threadIdx.x == 0) (void)xb_add(&bar[XB_XCNT(b.x)], 1u);
    return b;
}
__device__ __forceinline__ void xcd_barrier_complete(unsigned* bar, unsigned x, unsigned& nloc, unsigned& nx) {
    const unsigned G = gridDim.x * gridDim.y * gridDim.z;
    unsigned sum, cnt, mine, sp = 0u;
    for (;;) {
        sum = 0u; cnt = 0u; mine = 0u;
#pragma unroll
        for (unsigned j = 0; j < 16; ++j) { const unsigned c = xb_ld(&bar[XB_XCNT(j)]); sum += c; cnt += (c > 0u) ? 1u : 0u; mine = (j == x) ? c : mine; }
        if (sum == G) break;
        __builtin_amdgcn_s_sleep(1);
        if ((++sp & 255u) == 0u) { if (xb_ld(&bar[XB_TMO])) break; if (sp > XB_SPIN_CAP) { atomicAdd(&bar[XB_TMO], 1u); break; } }
    }
    nloc = mine > 0u ? mine : 1u; nx = cnt > 0u ? cnt : 1u;
}
__device__ __forceinline__ void xcd_barrier(const XcdBarrier& b) {
    asm volatile("s_waitcnt vmcnt(0)" ::: "memory");
    __syncthreads();
    if (threadIdx.x == 0) {
        unsigned* bar = b.bar;
        __builtin_amdgcn_s_waitcnt(0);
        unsigned nloc = b.st[0], nx = b.st[1];
        if (nloc == 0u) { xcd_barrier_complete(bar, b.x, nloc, nx); b.st[0] = nloc; b.st[1] = nx; }
        const unsigned old = xb_add(&bar[XB_XSUB(b.x)], 1u);
        const unsigned gen = old / nloc;
        if (old + 1u == (gen + 1u) * nloc) {
            __builtin_amdgcn_fence(__ATOMIC_RELEASE, "agent");
            asm volatile("s_waitcnt vmcnt(0)" ::: "memory");
            const unsigned og = xb_add(&bar[XB_TOP], 1u);
            const unsigned tg = og / nx;
            if (og + 1u == (tg + 1u) * nx) xb_add(&bar[XB_TOPGEN], 1u);
            else XB_SPIN(xb_ld(&bar[XB_TOPGEN]) == tg, bar);
            __builtin_amdgcn_fence(__ATOMIC_ACQUIRE, "agent");
            xb_add(&bar[XB_XGEN(b.x)], 1u);
            asm volatile("s_waitcnt vmcnt(0)" ::: "memory");
        } else {
            XB_SPIN(xb_ld(&bar[XB_XGEN(b.x)]) == gen, bar);
            __builtin_amdgcn_fence(__ATOMIC_ACQUIRE, "agent");
            asm volatile("s_waitcnt vmcnt(0)" ::: "memory");
        }
    }
    __syncthreads();
}

constexpr int NPHASE = 13;
constexpr int LDS_BYTES = 147456;
struct Args { const float* in[22]; float* out; unsigned char* ws; int ph_lo, ph_hi; };

__global__ void __launch_bounds__(512, 2) fwd(Args a) {
    extern __shared__ __attribute__((aligned(16))) unsigned char lds_raw[];
    LAS unsigned char* lds = (LAS unsigned char*)lds_raw;
    const int tid = threadIdx.x, lane = tid & 63, wave = __builtin_amdgcn_readfirstlane(tid >> 6);
    const int G = gridDim.x, bx = blockIdx.x;
    const int vcu = (G % 8 == 0) ? (bx % 8) * (G / 8) + bx / 8 : bx;
    const int gw = vcu * 8 + wave, ngw = G * 8;
    unsigned char* ws = a.ws;
    const float *x = a.in[0], *cvec = a.in[1], *ctx = a.in[2], *cctx = a.in[3], *wada = a.in[4], *bada = a.in[5], *ff1n = a.in[6], *ff1wi = a.in[7], *ff1wo = a.in[8],
                *mixn = a.in[9], *win = a.in[10], *qn = a.in[11], *kn = a.in[12], *rpb = a.in[13], *convw = a.in[14], *convb = a.in[15], *ona = a.in[16], *onc = a.in[17],
                *wout = a.in[18], *ff2n = a.in[19], *ff2wi = a.in[20], *ff2wo = a.in[21];
    float* mods = (float*)(ws + WS_MODS); float* ropec = (float*)(ws + WS_ROPE); float* ropes = ropec + 256 * 16; float* mpart = (float*)(ws + WS_MPART); float* ssq = (float*)(ws + WS_SSQ);
    bf16_t *Wt1 = (bf16_t*)(ws + WS_WT1), *Wt2 = (bf16_t*)(ws + WS_WT2), *Wt3 = (bf16_t*)(ws + WS_WT3), *Wt4 = (bf16_t*)(ws + WS_WT4), *Wt5 = (bf16_t*)(ws + WS_WT5), *Wt6 = (bf16_t*)(ws + WS_WT6);
    bf16_t *H = (bf16_t*)(ws + WS_H), *Gb = (bf16_t*)(ws + WS_G), *Qb = (bf16_t*)(ws + WS_Q), *Kb = (bf16_t*)(ws + WS_K), *Vt = (bf16_t*)(ws + WS_VT), *BG = (bf16_t*)(ws + WS_BG), *Zb = (bf16_t*)(ws + WS_Z);
    float* X1 = (float*)(ws + WS_X1);
    const int lo = a.ph_lo, hi = a.ph_hi;
    volatile LAS unsigned* MISC = (volatile LAS unsigned*)(lds + 131072 + 320);
    if (tid < 32) MISC[tid] = 0u;
    __syncthreads();
    unsigned* barw = (unsigned*)(ws + WS_BAR);
    XcdBarrier bar; bar.bar = barw; bar.x = 0; bar.st = MISC + 8;
#define IN(k) (lo <= (k) && (k) < hi)
#define SEAM(k) do { if (IN(k) && IN((k) + 1)) xcd_barrier(bar); } while (0)

    if (IN(0)) for (int rep = 0; rep < REP(0); ++rep) {
        constexpr int I_ADA = KSPLIT * 72, I_1 = (DM / 64) * (FF2 / 32), I_2 = (FF / 64) * (DM / 32), I_3 = (DM / 64) * (DIN / 32), I_4 = (DM / 64) * (DM / 32);
        constexpr int NIT = I_ADA + 2 * (I_1 + I_2) + I_3 + I_4;
        for (int it = gw; it < NIT; it += ngw) {
            int r = it;
            if (r < I_ADA) { ada_item(wada, cvec, cctx, mpart, r, lane); continue; } r -= I_ADA;
            if (r < I_1) { transpose_item(ff1wi, DM, FF2, Wt1, 1, r, lane); continue; } r -= I_1;
            if (r < I_2) { transpose_item(ff1wo, FF, DM, Wt2, 0, r, lane); continue; } r -= I_2;
            if (r < I_3) { transpose_item(win, DM, DIN, Wt3, 3, r, lane); continue; } r -= I_3;
            if (r < I_4) { transpose_item(wout, DM, DM, Wt4, 0, r, lane); continue; } r -= I_4;
            if (r < I_1) { transpose_item(ff2wi, DM, FF2, Wt5, 1, r, lane); continue; } r -= I_1;
            transpose_item(ff2wo, FF, DM, Wt6, 0, r, lane);
        }
    }
    if (IN(0) && IN(1)) {
        if (bx == 0) for (int i = tid; i < XCD_BAR_WORDS; i += 512) __hip_atomic_store(barw + i, 0u, __ATOMIC_RELAXED, __HIP_MEMORY_SCOPE_AGENT);
        asm volatile("s_waitcnt vmcnt(0)" ::: "memory");
        __ockl_grid_sync();
        bar = xcd_barrier_post(barw, MISC + 8);
    }
    if (IN(1)) for (int rep = 0; rep < REP(1); ++rep) {
        const int gt = bx * 512 + tid;
        if (gt < 2 * NMOD / 4) { const int v = gt / (NMOD / 4), j = (gt % (NMOD / 4)) * 4;
            f32x4 s = *(const f32x4*)(bada + j);
            for (int ks = 0; ks < KSPLIT; ++ks) s += *(const f32x4*)(mpart + (size_t)(ks * 2 + v) * NMOD + j);
            *(f32x4*)(mods + v * NMOD + j) = s; }
        else if (gt < 2 * NMOD / 4 + 4096) { const int idx = gt - 2 * NMOD / 4, pos = idx >> 4, i = idx & 15;
            const int i3 = i & 3; const float base4 = i3 == 0 ? 1.0f : i3 == 1 ? 0.5623413251903491f : i3 == 2 ? 0.31622776601683794f : 0.1778279410038923f;
            const int i2 = i >> 2; const float dec = i2 == 0 ? 1.0f : i2 == 1 ? 0.1f : i2 == 2 ? 0.01f : 0.001f;
            const float inv = base4 * dec;
            const float angf = (float)pos * inv;
            const double ang = (double)angf;
            const double r = ang - 6.283185307179586 * __builtin_rint(ang * 0.15915494309189535);
            const double r2 = r * r; double sn = r, cs = 1.0, ts = r, tc = 1.0;
#pragma unroll
            for (int k = 1; k <= 12; ++k) { tc = -tc * r2 / (double)((2 * k - 1) * (2 * k)); cs += tc; ts = -ts * r2 / (double)((2 * k) * (2 * k + 1)); sn += ts; }
            ropec[idx] = (float)cs; ropes[idx] = (float)sn; }
    }
    SEAM(1);
    if (IN(2)) for (int rep = 0; rep < REP(2); ++rep) norm_rows(x, ctx, MT, H, ff1n, mods, 0, 1, gw, ngw, lane);
    SEAM(2);
    if (IN(3)) for (int rep = 0; rep < REP(3); ++rep) { GSched S{(const char*)H, (const char*)Wt1, DM, 64, 44, 0, 0, G, bx}; EpiSwiGLU E{Gb}; pg8::gemm_phase(lds, DM, S, E);
        for (int u = vcu; u < 4 * 176; u += G) { const int rb2 = u & 3, jb = u >> 2, tile = jb >> 2, wq = (jb & 3) * 32;
            const bf16_t* w0 = Wt1 + (size_t)(256 * tile + wq) * DM;
            bf16_t* gp = Gb + (size_t)(SEQ + 64 * rb2) * FF + 32 * jb;
            wg_gemm64(H + (size_t)(SEQ + 64 * rb2) * DM, w0, w0 + (size_t)128 * DM, DM, lds, wave, lane,
                      [&](int r, int c, float va, float vb) { gp[(size_t)r * FF + c] = (bf16_t)(cvt_pk_bf16(silu_f(va) * vb, 0.f) & 0xffffu); }); } }
    SEAM(3);
    if (IN(4)) for (int rep = 0; rep < REP(4); ++rep) { GSched S{(const char*)Gb, (const char*)Wt2, FF, 64, 8, 0, 0, G, bx}; EpiResid E{x, ctx, X1, mods + 2 * DM, mods + NMOD + 2 * DM, 0.5f}; pg8::gemm_phase(lds, FF, S, E);
        for (int u = vcu; u < 4 * 32; u += G) { const int rb2 = u & 3, cb2 = u >> 2;
            const bf16_t* w0 = Wt2 + (size_t)(64 * cb2) * FF;
            const float* bp = ctx + (size_t)(64 * rb2) * DM + 64 * cb2; float* op = X1 + (size_t)(SEQ + 64 * rb2) * DM + 64 * cb2; const float* gp = mods + NMOD + 2 * DM + 64 * cb2;
            wg_gemm64(Gb + (size_t)(SEQ + 64 * rb2) * FF, w0, w0 + (size_t)32 * FF, FF, lds, wave, lane,
                      [&](int r, int c, float va, float vb) { op[(size_t)r * DM + c] = bp[(size_t)r * DM + c] + 0.5f * gp[c] * va; op[(size_t)r * DM + c + 32] = bp[(size_t)r * DM + c + 32] + 0.5f * gp[c + 32] * vb; }); } }
    SEAM(4);
    if (IN(5)) for (int rep = 0; rep < REP(5); ++rep) norm_rows(X1, X1 + (size_t)SEQ * DM, MT, H, mixn, mods, 3, 4, gw, ngw, lane);
    SEAM(5);
    if (IN(6)) for (int rep = 0; rep < REP(6); ++rep) { GSched S{(const char*)H, (const char*)Wt3, DM, 64, 20, 4 * 64, 3, G, bx}; EpiInProj E{Qb, Kb, Vt, BG, Zb, qn, kn, ropec, ropes}; pg8::gemm_phase(lds, DM, S, E);
        for (int u = vcu; u < 128; u += G) {
            if (u < 64) { const int rb2 = u & 3, hd = u >> 2;
                const bf16_t* w0 = Wt3 + (size_t)(1024 + 256 * (hd >> 2) + 32 * (hd & 3)) * DM;
                bf16_t* kp = Kb + (size_t)(SEQ + 64 * rb2) * DA + 64 * hd;
                wg_gemm64(H + (size_t)(SEQ + 64 * rb2) * DM, w0, w0 + (size_t)128 * DM, DM, lds, wave, lane,
                          [&](int r, int c, float va, float vb) { float ss = va * va + vb * vb;
#pragma unroll
                              for (int o = 1; o < 32; o <<= 1) ss += __shfl_xor(ss, o);
                              const float rinv = __builtin_amdgcn_rsqf(ss * (1.0f / 64.0f) + EPS); const int d = 16 * ((c >> 2) & 1) + 4 * (c >> 3) + (c & 3);
                              kp[(size_t)r * DA + d] = (bf16_t)(cvt_pk_bf16(va * rinv * kn[d], 0.f) & 0xffffu); kp[(size_t)r * DA + d + 32] = (bf16_t)(cvt_pk_bf16(vb * rinv * kn[d + 32], 0.f) & 0xffffu); }); }
            else { const int v = u - 64, hb = v >> 2, tb = v & 3;
                const bf16_t* w0 = H + (size_t)(SEQ + 64 * tb) * DM;
                bf16_t* vp = Vt + (size_t)(64 * hb) * MT + SEQ + 64 * tb;
                wg_gemm64(Wt3 + (size_t)(2048 + 64 * hb) * DM, w0, w0 + (size_t)32 * DM, DM, lds, wave, lane,
                          [&](int r, int c, float va, float vb) { vp[(size_t)r * MT + c] = (bf16_t)(cvt_pk_bf16(va, 0.f) & 0xffffu); vp[(size_t)r * MT + c + 32] = (bf16_t)(cvt_pk_bf16(vb, 0.f) & 0xffffu); }); }
        } }
    SEAM(6);
    if (IN(7)) for (int rep = 0; rep < REP(7); ++rep) {
        LAS float* tab = (LAS float*)(lds + wave * 4096);
        for (int u = gw; u < NH * 512; u += ngw) attn_unit(u, Qb, Kb, Vt, rpb, H, ssq, tab, lane);
        conv_rows(BG, Zb, convw, convb, onc, H, gw, ngw, lane);
    }
    SEAM(7);
    if (IN(8)) for (int rep = 0; rep < REP(8); ++rep) ynorm_rows(H, ssq, ona, gw, ngw, lane);
    SEAM(8);
    if (IN(9)) for (int rep = 0; rep < REP(9); ++rep) { GSched S{(const char*)H, (const char*)Wt4, DM, 64, 8, 0, 0, G, bx}; EpiResid E{X1, X1, X1, mods + 5 * DM, mods + 5 * DM, 1.0f}; pg8::gemm_phase(lds, DM, S, E); }
    SEAM(9);
    if (IN(10)) for (int rep = 0; rep < REP(10); ++rep) norm_rows(X1, X1, SEQ, H, ff2n, mods, 6, 7, gw, ngw, lane);
    SEAM(10);
    if (IN(11)) for (int rep = 0; rep < REP(11); ++rep) { GSched S{(const char*)H, (const char*)Wt5, DM, 64, 44, 0, 0, G, bx}; EpiSwiGLU E{Gb}; pg8::gemm_phase(lds, DM, S, E); }
    SEAM(11);
    if (IN(12)) for (int rep = 0; rep < REP(12); ++rep) { GSched S{(const char*)Gb, (const char*)Wt6, FF, 64, 8, 0, 0, G, bx}; EpiResid E{X1, X1, a.out, mods + 8 * DM, mods + 8 * DM, 0.5f}; pg8::gemm_phase(lds, FF, S, E); }
#undef IN
#undef SEAM
}

extern "C" void kernel_launch(void* const* d_in, const int* in_sizes, int n_in, void* d_out, int out_size, void* d_ws, size_t ws_size, hipStream_t stream) {
    static int grid = 0;
    if (grid == 0) {
        if (n_in != 22 || out_size != SEQ * DM || ws_size < WS_END) { fprintf(stderr, "kernel_launch: unexpected shapes (n_in %d out %d ws %zu)\n", n_in, out_size, ws_size); grid = -1; return; }
        int dev = 0, cus = 0, per_cu = 0;
        if (hipGetDevice(&dev) != hipSuccess || hipDeviceGetAttribute(&cus, hipDeviceAttributeMultiprocessorCount, dev) != hipSuccess) { grid = -1; return; }
        if (hipFuncSetAttribute((const void*)fwd, hipFuncAttributeMaxDynamicSharedMemorySize, LDS_BYTES) != hipSuccess) { fprintf(stderr, "kernel_launch: hipFuncSetAttribute failed\n"); grid = -1; return; }
        if (hipOccupancyMaxActiveBlocksPerMultiprocessor(&per_cu, (const void*)fwd, 512, LDS_BYTES) != hipSuccess || per_cu < 1) { fprintf(stderr, "kernel_launch: occupancy query says %d\n", per_cu); per_cu = 1; }
        (void)hipGetLastError();
        grid = cus;
    }
    if (grid < 0) return;
    Args a{};
    for (int i = 0; i < 22; ++i) a.in[i] = (const float*)d_in[i];
    a.out = (float*)d_out; a.ws = (unsigned char*)d_ws;
    if (MK_N_LAUNCHES == 1) {
        a.ph_lo = 0; a.ph_hi = NPHASE;
        void* args[] = {&a};
        hipError_t e = hipLaunchCooperativeKernel((const void*)fwd, dim3(grid), dim3(512), args, LDS_BYTES, stream);
        if (e != hipSuccess) fprintf(stderr, "cooperative launch failed: %s (grid %d)\n", hipGetErrorString(e), grid);
    } else {
        for (int p = 0; p < NPHASE; ++p) { a.ph_lo = p; a.ph_hi = p + 1; hipLaunchKernelGGL(fwd, dim3(grid), dim3(512), LDS_BYTES, stream, a); }
    }
}
```

```cpp
#include <hip/hip_runtime.h>
#include <cstdio>
#include <cstdint>

#define LAS __attribute__((address_space(3)))
typedef unsigned short bf16_t;
typedef short bf16x8 __attribute__((ext_vector_type(8)));
typedef float f32x4 __attribute__((ext_vector_type(4)));
typedef float f32x16 __attribute__((ext_vector_type(16)));
typedef unsigned u32x4 __attribute__((ext_vector_type(4)));
typedef unsigned u32x2 __attribute__((ext_vector_type(2)));

#ifdef TPROBE_LO
#define TP_START(k) do { if ((k) == TPROBE_LO && bx == 0 && tid == 0) { const unsigned long long t_ = __builtin_amdgcn_s_memrealtime(); MISC[16] = (unsigned)t_; MISC[17] = (unsigned)(t_ >> 32); } } while (0)
#define TP_END(k) do { if ((k) == TPROBE_HI && bx == 0 && tid == 0) { const unsigned long long t_ = __builtin_amdgcn_s_memrealtime(); MISC[18] = (unsigned)t_; MISC[19] = (unsigned)(t_ >> 32); } } while (0)
#else
#define TP_START(k) do {} while (0)
#define TP_END(k) do {} while (0)
#endif
#ifndef PROBE_MASK
#define PROBE_MASK 0
#endif
#define REP(k) ((((PROBE_MASK) >> (k)) & 1) ? 2 : 1)
#ifndef MK_N_LAUNCHES
#define MK_N_LAUNCHES 1
#endif

constexpr int SEQ = 16384, CTX = 256, MT = SEQ + CTX, DM = 2048, FF = 5632, FF2 = 2 * FF, DIN = 6144, DA = 1024, NH = 16;
constexpr int NMOD = 9 * DM;
constexpr float EPS = 1e-6f, LOG2E = 1.4426950408889634f;
constexpr int KSPLIT = 32;

constexpr size_t MiB = 1u << 20;
constexpr size_t WS_MODS = 0;
constexpr size_t WS_ROPE = 256 * 1024;
constexpr size_t WS_MPART = 1 * MiB;
constexpr size_t WS_BAR = 512 * 1024;
constexpr size_t WS_SSQ = 6 * MiB;
constexpr size_t WS_SSQ2 = 7 * MiB;
constexpr size_t WS_C5 = 7 * MiB + 128 * 1024;
constexpr size_t WS_C3 = 7 * MiB + 192 * 1024;
constexpr size_t WS_C3C = 7 * MiB + 224 * 1024;
constexpr size_t WS_SSQ1 = 7 * MiB + 256 * 1024;
constexpr size_t WS_WT1 = 8 * MiB, WS_WT2 = 52 * MiB, WS_WT3 = 74 * MiB, WS_WT4 = 98 * MiB, WS_WT5 = 106 * MiB, WS_WT6 = 150 * MiB;
constexpr size_t WS_H = 172 * MiB;
constexpr size_t WS_X1 = 237 * MiB;
constexpr size_t WS_G = 367 * MiB;
constexpr size_t WS_Q = 367 * MiB, WS_K = 399 * MiB, WS_VT = 432 * MiB, WS_BG = 465 * MiB, WS_Z = 497 * MiB;
constexpr size_t WS_A2 = 8 * MiB;
constexpr size_t WS_WT3U = 546 * MiB;
constexpr size_t WS_END = 554 * MiB;

__device__ __forceinline__ unsigned cvt_pk_bf16(float lo, float hi) { unsigned r; asm("v_cvt_pk_bf16_f32 %0, %1, %2" : "=v"(r) : "v"(lo), "v"(hi)); return r; }
__device__ __forceinline__ float bf2f(unsigned short b) { return __builtin_bit_cast(float, (unsigned)b << 16); }
__device__ __forceinline__ float wave_sum(float v) {
#pragma unroll
    for (int o = 1; o < 64; o <<= 1) v += __shfl_xor(v, o);
    return v;
}
__device__ __forceinline__ float silu_f(float a) { return a * __builtin_amdgcn_rcpf(1.0f + __builtin_amdgcn_exp2f(-a * LOG2E)); }

namespace pg8 {
constexpr int BM = 256, BK = 64, HALF = 128, HTB = HALF * BK * 2, STAGE_BYTES = 8 * HTB, NXCD = 8, WGM = 8;
__host__ __device__ __forceinline__ int lds_byte(int r, int c) { const int st = (r >> 4) * 2 + (c >> 5), rr = r & 15, cc = c & 31, ob = rr * 64 + cc * 2; return st * 1024 + (ob ^ (((ob >> 9) & 1) << 5)); }
__host__ __device__ __forceinline__ void stage_rc(int b, int& R, int& C) { const int st = b / 1024, sb = b % 1024, swz = sb ^ (((sb >> 9) & 1) << 5); R = (st >> 1) * 16 + swz / 64; C = (st & 1) * 32 + (swz % 64) / 2; }
__host__ __device__ __forceinline__ int perm32(int rho) { const int n = rho >> 4, i = rho & 15; return 8 * (i >> 2) + 4 * n + (i & 3); }

struct Unit { int pm, pn, kind; const char* pa; const char* pb; };

template <class Epi, class Sched>
__device__ __forceinline__ void gemm_phase(LAS unsigned char* lds, const int K, const Sched& S, const Epi& E) {
    const int tid = threadIdx.x, wid = __builtin_amdgcn_readfirstlane(tid >> 6), lane = tid & 63, wr = wid >> 2, wc = wid & 3, fr = lane & 15, fq = lane >> 4;
    const int nt = K / BK;
    unsigned voffA[2], voffB[2];
#pragma unroll
    for (int i = 0; i < 2; ++i) { int R, C; stage_rc(tid * 16 + i * 8192, R, C); const int Rb = (R & ~31) + perm32(R & 31);
        voffA[i] = (unsigned)(R * K + C) * 2u; voffB[i] = (unsigned)(Rb * K + C) * 2u; }
    const size_t kstep = (size_t)(BK * 2);
    const size_t hstep = (size_t)HALF * K * 2;
    const unsigned ldsw = (unsigned)wid * 1024u;
    const int aoff = lds_byte(wr * 64 + fr, fq * 8), boff = lds_byte(wc * 32 + fr, fq * 8);
#define PG8_SA(b, h) (((b) * 2 + (h)) * HTB)
#define PG8_SB(b, h) ((4 + (b) * 2 + (h)) * HTB)
#define PG8_STAGE(bufoff, gbase, voff) do { _Pragma("unroll") for (int _i = 0; _i < 2; ++_i) \
        __builtin_amdgcn_global_load_lds((const unsigned*)((const char*)(gbase) + (voff)[_i]), (LAS unsigned*)(lds + (bufoff) + ldsw + _i * 8192), 16, 0, 0); } while (0)
#define PG8_LDA(dst, b, h) do { _Pragma("unroll") for (int m = 0; m < 4; ++m) _Pragma("unroll") for (int k = 0; k < 2; ++k) dst[m][k] = *(const LAS bf16x8*)(lds + PG8_SA(b, h) + aoff + m * 2048 + k * 1024); } while (0)
#define PG8_LDB(dst, b, h) do { _Pragma("unroll") for (int n = 0; n < 2; ++n) _Pragma("unroll") for (int k = 0; k < 2; ++k) dst[n][k] = *(const LAS bf16x8*)(lds + PG8_SB(b, h) + boff + n * 2048 + k * 1024); } while (0)
#define PG8_MMA(ai, bj, At, Bt) do { __builtin_amdgcn_s_setprio(1); _Pragma("unroll") for (int m = 0; m < 4; ++m) _Pragma("unroll") for (int n = 0; n < 2; ++n) _Pragma("unroll") for (int k = 0; k < 2; ++k) \
        acc[ai][bj][m][n] = __builtin_amdgcn_mfma_f32_16x16x32_bf16(Bt[n][k], At[m][k], acc[ai][bj][m][n], 0, 0, 0); __builtin_amdgcn_s_setprio(0); } while (0)
#define PG8_WAIT_V(n) asm volatile("s_waitcnt vmcnt(" #n ")" ::: "memory")
#define PG8_WAIT_L(n) asm volatile("s_waitcnt lgkmcnt(" #n ")" ::: "memory")
#define PG8_BAR __builtin_amdgcn_s_barrier()
#define PG8_SCHED __builtin_amdgcn_sched_barrier(0)
    Unit cur, nxt; int ui = 0;
    if (!S.next(0, cur)) return;
    f32x4 acc[2][2][4][2];
#pragma unroll
    for (int a = 0; a < 2; ++a)
#pragma unroll
        for (int b = 0; b < 2; ++b)
#pragma unroll
            for (int m = 0; m < 4; ++m)
#pragma unroll
                for (int n = 0; n < 2; ++n) acc[a][b][m][n] = (f32x4){0.f, 0.f, 0.f, 0.f};
    bf16x8 At[4][2], B0[2][2], B1[2][2];
    const char* cA = cur.pa; const char* cB = cur.pb;
    PG8_STAGE(PG8_SB(0, 0), cB, voffB); PG8_STAGE(PG8_SB(0, 1), cB + hstep, voffB); PG8_STAGE(PG8_SA(0, 0), cA, voffA); PG8_STAGE(PG8_SA(0, 1), cA + hstep, voffA);
    if (wr == 1) PG8_BAR;
    PG8_WAIT_V(2); PG8_BAR;
    PG8_STAGE(PG8_SB(1, 0), cB + kstep, voffB); PG8_STAGE(PG8_SA(1, 0), cA + kstep, voffA); PG8_STAGE(PG8_SB(1, 1), cB + hstep + kstep, voffB);
    PG8_WAIT_V(6); PG8_BAR;
    for (;;) {
        const bool has_next = S.next(ui + 1, nxt);
        const char* nA = has_next ? nxt.pa : cA; const char* nB = has_next ? nxt.pb : cB;
        for (int t = 0; t < nt; t += 2) {
            const bool last = (t == nt - 2);
            if constexpr (Epi::MID) { if (t == (nt >> 1)) E.mid(acc, cur, wr, fr); }
            const char* a1 = cA + (size_t)(t + 1) * kstep;
            const char* a2 = last ? nA : cA + (size_t)(t + 2) * kstep; const char* b2 = last ? nB : cB + (size_t)(t + 2) * kstep;
            const char* a3 = a2 + kstep; const char* b3 = b2 + kstep;
            PG8_LDB(B0, 0, 0); PG8_LDB(B1, 0, 1); PG8_SCHED; PG8_LDA(At, 0, 0); PG8_STAGE(PG8_SA(1, 1), a1 + hstep, voffA);
            PG8_WAIT_V(8); PG8_WAIT_L(0); PG8_BAR; PG8_MMA(0, 0, At, B0); PG8_MMA(0, 1, At, B1); PG8_BAR; PG8_SCHED;
            PG8_LDA(At, 0, 1); PG8_STAGE(PG8_SB(0, 0), b2, voffB); PG8_STAGE(PG8_SB(0, 1), b2 + hstep, voffB); PG8_STAGE(PG8_SA(0, 0), a2, voffA);
            PG8_WAIT_V(8); PG8_WAIT_L(0); PG8_BAR; PG8_MMA(1, 0, At, B0); PG8_MMA(1, 1, At, B1); PG8_BAR; PG8_SCHED;
            PG8_LDB(B0, 1, 0); PG8_LDB(B1, 1, 1); PG8_SCHED; PG8_LDA(At, 1, 0); PG8_STAGE(PG8_SA(0, 1), a2 + hstep, voffA);
            PG8_WAIT_V(8); PG8_WAIT_L(0); PG8_BAR; PG8_MMA(0, 0, At, B0); PG8_MMA(0, 1, At, B1); PG8_BAR; PG8_SCHED;
            PG8_LDA(At, 1, 1); PG8_STAGE(PG8_SB(1, 0), b3, voffB); PG8_STAGE(PG8_SB(1, 1), b3 + hstep, voffB); PG8_STAGE(PG8_SA(1, 0), a3, voffA);
            PG8_WAIT_V(8); PG8_WAIT_L(0); PG8_BAR; PG8_MMA(1, 0, At, B0); PG8_MMA(1, 1, At, B1); PG8_BAR; PG8_SCHED;
        }
        if (wr == 0) PG8_BAR;
        E(acc, cur, wr, wc, fr, fq);
        if (!has_next) break;
#pragma unroll
        for (int a = 0; a < 2; ++a)
#pragma unroll
            for (int b = 0; b < 2; ++b)
#pragma unroll
                for (int m = 0; m < 4; ++m)
#pragma unroll
                    for (int n = 0; n < 2; ++n) acc[a][b][m][n] = (f32x4){0.f, 0.f, 0.f, 0.f};
        cur = nxt; cA = nA; cB = nB; ++ui;
        if (wr == 1) PG8_BAR;
    }
    PG8_WAIT_V(0);
    PG8_BAR;
#undef PG8_SA
#undef PG8_SB
#undef PG8_STAGE
#undef PG8_LDA
#undef PG8_LDB
#undef PG8_MMA
#undef PG8_WAIT_V
#undef PG8_WAIT_L
#undef PG8_BAR
#undef PG8_SCHED
}
}

enum { KQ = 0, KK = 1, KKCTX = 2, KBG = 3, KZ = 4, KVT = 5 };
struct GSched {
    const char* A; const char* B; int K, nM, nN, nX, mode, G, c;
    __device__ __forceinline__ bool next(int i, pg8::Unit& u) const {
        const int nwg = nM * nN; const long L = (long)i * G + c; if (L >= nwg + nX) return false;
        const size_t tstep = (size_t)256 * K * 2;
        if (L < nwg) {
            int wgid = (int)L; { const int q = nwg / pg8::NXCD, r = nwg % pg8::NXCD, xcd = wgid % pg8::NXCD, off = wgid / pg8::NXCD; wgid = (xcd < r ? xcd * (q + 1) : r * (q + 1) + (xcd - r) * q) + off; }
            const int nig = pg8::WGM * nN, gid = wgid / nig, fm = gid * pg8::WGM, gsz = (nM - fm) < pg8::WGM ? (nM - fm) : pg8::WGM;
            const int pm = fm + ((wgid % nig) % gsz), pi = (wgid % nig) / gsz;
            int pnB = pi, kind = 0;
            if (mode == 3) { pnB = pi < 8 ? pi : pi + 4; kind = pi < 4 ? KQ : pi < 8 ? KK : pi < 12 ? KBG : KZ; }
            u.pm = pm; u.pn = pnB; u.kind = kind; u.pa = A + (size_t)pm * tstep; u.pb = B + (size_t)pnB * tstep;
        } else {
            const int x = (int)(L - nwg);
            if (mode != 3) { u.pm = nM; u.pn = x; u.kind = 0; u.pa = A + (size_t)nM * tstep; u.pb = B + (size_t)x * tstep; }
            else { const int pmv = x >> 6, pnv = x & 63; u.pm = pmv; u.pn = pnv; u.kind = KVT; u.pa = B + (size_t)(8 + pmv) * tstep; u.pb = A + (size_t)pnv * tstep; }
        }
        return true;
    }
};

typedef f32x4 Acc[2][2][4][2];
template <bool ROWN> struct EpiSwiGLU {
    static constexpr bool MID = false;
    bf16_t* G; const float* ssq; const float* cvec;
    __device__ __forceinline__ void operator()(const Acc& acc, const pg8::Unit& u, int wr, int wc, int fr, int fq) const {
        const int row0 = u.pm * 256 + wr * 64 + fr, col0 = u.pn * 128 + wc * 32 + 8 * fq;
        f32x4 ca[2], cb[2];
        if (ROWN) {
#pragma unroll
            for (int n = 0; n < 2; ++n) { ca[n] = *(const f32x4*)(cvec + u.pn * 256 + wc * 32 + 8 * fq + 4 * n); cb[n] = *(const f32x4*)(cvec + u.pn * 256 + 128 + wc * 32 + 8 * fq + 4 * n); } }
#pragma unroll
        for (int ai = 0; ai < 2; ++ai)
#pragma unroll
            for (int m = 0; m < 4; ++m) {
                const int r = row0 + ai * 128 + m * 16;
                bf16_t* p = G + (size_t)r * FF + col0;
                f32x4 a0 = acc[ai][0][m][0], a1 = acc[ai][0][m][1], b0 = acc[ai][1][m][0], b1 = acc[ai][1][m][1];
                if (ROWN) { const float rinv = __builtin_amdgcn_rsqf(ssq[r] * (1.0f / DM) + EPS);
                    a0 = a0 * rinv + ca[0]; a1 = a1 * rinv + ca[1]; b0 = b0 * rinv + cb[0]; b1 = b1 * rinv + cb[1]; }
                u32x4 w;
                w.x = cvt_pk_bf16(silu_f(a0[0]) * b0[0], silu_f(a0[1]) * b0[1]); w.y = cvt_pk_bf16(silu_f(a0[2]) * b0[2], silu_f(a0[3]) * b0[3]);
                w.z = cvt_pk_bf16(silu_f(a1[0]) * b1[0], silu_f(a1[1]) * b1[1]); w.w = cvt_pk_bf16(silu_f(a1[2]) * b1[2], silu_f(a1[3]) * b1[3]);
                *(u32x4*)p = w;
            }
    }
};
template <bool EMIT, bool MIDH, bool BB, bool OB> struct EpiResid {
    const void* base; void* out; const float* gate; float s; float* ssq; const float* ssqA;
    static constexpr bool MID = MIDH;
    __device__ __forceinline__ void mid(Acc& acc, const pg8::Unit& u, int wr, int fr) const {
        const int row0 = u.pm * 256 + wr * 64 + fr;
#pragma unroll
        for (int ai = 0; ai < 2; ++ai)
#pragma unroll
            for (int m = 0; m < 4; ++m) { const float ra = __builtin_amdgcn_rsqf(ssqA[row0 + ai * 128 + m * 16] * (1.0f / DA) + EPS);
#pragma unroll
                for (int bj = 0; bj < 2; ++bj)
#pragma unroll
                    for (int n = 0; n < 2; ++n) acc[ai][bj][m][n] *= ra; }
    }
    __device__ __forceinline__ void operator()(const Acc& acc, const pg8::Unit& u, int wr, int wc, int fr, int fq) const {
        const int row0 = u.pm * 256 + wr * 64 + fr, col0 = u.pn * 256 + wc * 32 + 8 * fq;
        f32x4 gv[2][2];
#pragma unroll
        for (int bj = 0; bj < 2; ++bj)
#pragma unroll
            for (int n = 0; n < 2; ++n) gv[bj][n] = *(const f32x4*)(gate + col0 + bj * 128 + 4 * n) * s;
#pragma unroll
        for (int ai = 0; ai < 2; ++ai)
#pragma unroll
            for (int m = 0; m < 4; ++m) {
                const int r = row0 + ai * 128 + m * 16;
                const size_t off = (size_t)r * DM + col0;
                float ss = 0.f;
#pragma unroll
                for (int bj = 0; bj < 2; ++bj) {
                    f32x4 b0, b1;
                    if (BB) { const bf16x8 bv = *(const bf16x8*)((const bf16_t*)base + off + bj * 128);
                        b0 = (f32x4){bf2f((unsigned short)bv[0]), bf2f((unsigned short)bv[1]), bf2f((unsigned short)bv[2]), bf2f((unsigned short)bv[3])};
                        b1 = (f32x4){bf2f((unsigned short)bv[4]), bf2f((unsigned short)bv[5]), bf2f((unsigned short)bv[6]), bf2f((unsigned short)bv[7])}; }
                    else { b0 = __builtin_nontemporal_load((const f32x4*)((const float*)base + off + bj * 128)); b1 = __builtin_nontemporal_load((const f32x4*)((const float*)base + off + bj * 128 + 4)); }
                    const f32x4 o0 = b0 + gv[bj][0] * acc[ai][bj][m][0], o1 = b1 + gv[bj][1] * acc[ai][bj][m][1];
                    if (OB) { u32x4 w; w.x = cvt_pk_bf16(o0[0], o0[1]); w.y = cvt_pk_bf16(o0[2], o0[3]); w.z = cvt_pk_bf16(o1[0], o1[1]); w.w = cvt_pk_bf16(o1[2], o1[3]);
                        *(u32x4*)((bf16_t*)out + off + bj * 128) = w; }
                    else { *(f32x4*)((float*)out + off + bj * 128) = o0; *(f32x4*)((float*)out + off + bj * 128 + 4) = o1; }
                    if (EMIT) ss += (o0[0] * o0[0] + o0[1] * o0[1]) + (o0[2] * o0[2] + o0[3] * o0[3]) + (o1[0] * o1[0] + o1[1] * o1[1]) + (o1[2] * o1[2] + o1[3] * o1[3]);
                }
                if (EMIT) { ss += __shfl_xor(ss, 16); ss += __shfl_xor(ss, 32); if (fq == 0) unsafeAtomicAdd(ssq + r, ss); }
            }
    }
};
struct EpiInProj {
    static constexpr bool MID = false;
    bf16_t *Q, *Kb, *Vt, *BG, *Z; const float *qn, *kn, *rc, *rs; const float *ssq1, *c3;
    __device__ __forceinline__ float rinv_row(int r) const { return __builtin_amdgcn_rsqf(ssq1[r] * (1.0f / DM) + EPS); }
    __device__ __forceinline__ void qk(const Acc& acc, const f32x4 (&cv)[2][2], int row0, bf16_t* dst, int head, const float* gain, float oscale, int fq) const {
        f32x4 g[2][2];
#pragma unroll
        for (int bj = 0; bj < 2; ++bj)
#pragma unroll
            for (int n = 0; n < 2; ++n) g[bj][n] = *(const f32x4*)(gain + 32 * bj + 16 * n + 4 * fq);
#pragma unroll
        for (int ai = 0; ai < 2; ++ai)
#pragma unroll
            for (int m = 0; m < 4; ++m) {
                const int r = row0 + ai * 128 + m * 16;
                const float ri = rinv_row(r);
                f32x4 v[2][2];
                float ss = 0.f;
#pragma unroll
                for (int bj = 0; bj < 2; ++bj)
#pragma unroll
                    for (int n = 0; n < 2; ++n) { v[bj][n] = acc[ai][bj][m][n] * ri + cv[bj][n]; const f32x4 t = v[bj][n]; ss += (t[0] * t[0] + t[1] * t[1]) + (t[2] * t[2] + t[3] * t[3]); }
                ss += __shfl_xor(ss, 16); ss += __shfl_xor(ss, 32);
                const float rinv = __builtin_amdgcn_rsqf(ss * (1.0f / 64.0f) + EPS) * oscale;
                bf16_t* p = dst + (size_t)r * DA + head * 64 + 4 * fq;
#pragma unroll
                for (int bj = 0; bj < 2; ++bj) {
                    const f32x4 y0 = v[bj][0] * rinv * g[bj][0], y1 = v[bj][1] * rinv * g[bj][1];
                    const int pos = bj ? (r & 63) : (r >> 6);
                    const f32x4 C = *(const f32x4*)(rc + pos * 16 + 4 * fq), Sn = *(const f32x4*)(rs + pos * 16 + 4 * fq);
                    const f32x4 o1 = y0 * C - y1 * Sn, o2 = y0 * Sn + y1 * C;
                    u32x2 w1, w2; w1.x = cvt_pk_bf16(o1[0], o1[1]); w1.y = cvt_pk_bf16(o1[2], o1[3]); w2.x = cvt_pk_bf16(o2[0], o2[1]); w2.y = cvt_pk_bf16(o2[2], o2[3]);
                    *(u32x2*)(p + 32 * bj) = w1; *(u32x2*)(p + 32 * bj + 16) = w2;
                }
            }
    }
    __device__ __forceinline__ void operator()(const Acc& acc, const pg8::Unit& u, int wr, int wc, int fr, int fq) const {
        asm volatile("" : "+v"(fr), "+v"(fq));
        const int row0 = u.pm * 256 + wr * 64 + fr;
        if (u.kind == KVT) {
            f32x4 rv[2][2];
#pragma unroll
            for (int bj = 0; bj < 2; ++bj)
#pragma unroll
                for (int n = 0; n < 2; ++n) { const f32x4 q = *(const f32x4*)(ssq1 + u.pn * 256 + bj * 128 + wc * 32 + 8 * fq + 4 * n);
                    rv[bj][n] = (f32x4){__builtin_amdgcn_rsqf(q[0] * (1.0f / DM) + EPS), __builtin_amdgcn_rsqf(q[1] * (1.0f / DM) + EPS), __builtin_amdgcn_rsqf(q[2] * (1.0f / DM) + EPS), __builtin_amdgcn_rsqf(q[3] * (1.0f / DM) + EPS)}; }
            const int col0 = u.pn * 256 + wc * 32 + 8 * fq;
#pragma unroll
            for (int ai = 0; ai < 2; ++ai)
#pragma unroll
                for (int m = 0; m < 4; ++m) { const float cr = c3[2048 + row0 + ai * 128 + m * 16];
#pragma unroll
                    for (int bj = 0; bj < 2; ++bj) {
                        const f32x4 v0 = acc[ai][bj][m][0] * rv[bj][0] + cr, v1 = acc[ai][bj][m][1] * rv[bj][1] + cr;
                        u32x4 w; w.x = cvt_pk_bf16(v0[0], v0[1]); w.y = cvt_pk_bf16(v0[2], v0[3]); w.z = cvt_pk_bf16(v1[0], v1[1]); w.w = cvt_pk_bf16(v1[2], v1[3]);
                        *(u32x4*)(Vt + (size_t)(row0 + ai * 128 + m * 16) * MT + col0 + bj * 128) = w; } }
            return;
        }
        f32x4 cv[2][2];
#pragma unroll
        for (int bj = 0; bj < 2; ++bj)
#pragma unroll
            for (int n = 0; n < 2; ++n) cv[bj][n] = *(const f32x4*)(c3 + u.pn * 256 + bj * 128 + wc * 32 + 8 * fq + 4 * n);
        if (u.kind == KQ) { qk(acc, cv, row0, Q, 4 * u.pn + wc, qn, 0.125f * LOG2E, fq); }
        else if (u.kind == KK) { qk(acc, cv, row0, Kb, 4 * (u.pn - 4) + wc, kn, 1.0f, fq); }
        else if (u.kind == KZ) {
            const int col0 = (u.pn - 16) * 128 + wc * 32 + 8 * fq;
#pragma unroll
            for (int ai = 0; ai < 2; ++ai)
#pragma unroll
                for (int m = 0; m < 4; ++m) { const int r = row0 + ai * 128 + m * 16; const float ri = rinv_row(r);
                    const f32x4 z0 = (acc[ai][0][m][0] * ri + cv[0][0]) * (acc[ai][1][m][0] * ri + cv[1][0]), z1 = (acc[ai][0][m][1] * ri + cv[0][1]) * (acc[ai][1][m][1] * ri + cv[1][1]);
                    u32x4 w; w.x = cvt_pk_bf16(z0[0], z0[1]); w.y = cvt_pk_bf16(z0[2], z0[3]); w.z = cvt_pk_bf16(z1[0], z1[1]); w.w = cvt_pk_bf16(z1[2], z1[3]);
                    *(u32x4*)(Z + (size_t)r * DA + col0) = w; }
        } else {
            const int col0 = (u.pn - 12) * 256 + wc * 32 + 8 * fq;
#pragma unroll
            for (int ai = 0; ai < 2; ++ai)
#pragma unroll
                for (int m = 0; m < 4; ++m) { const int r = row0 + ai * 128 + m * 16; const float ri = rinv_row(r);
#pragma unroll
                    for (int bj = 0; bj < 2; ++bj) {
                        const f32x4 v0 = acc[ai][bj][m][0] * ri + cv[bj][0], v1 = acc[ai][bj][m][1] * ri + cv[bj][1];
                        u32x4 w; w.x = cvt_pk_bf16(v0[0], v0[1]); w.y = cvt_pk_bf16(v0[2], v0[3]); w.z = cvt_pk_bf16(v1[0], v1[1]); w.w = cvt_pk_bf16(v1[2], v1[3]);
                        *(u32x4*)(BG + (size_t)r * DA + col0 + bj * 128) = w; } }
        }
    }
};

__device__ __forceinline__ int colmap(int mode, int np) {
    if (mode == 1) { const int tile = np >> 8, w = np & 255; return (w >> 7) * FF + tile * 128 + (w & 127); }
    if (mode == 3) {
        if (np < 2048) { const int base = np & ~1023, rel = np & 1023, tile = rel >> 8, w = rel & 255;
            const int bj = w >> 7, wc = (w >> 5) & 3, fq = (w >> 3) & 3, n = (w >> 2) & 1, e = w & 3;
            return base + 64 * (4 * tile + wc) + 32 * bj + 16 * n + 4 * fq + e; }
        if (np < 4096) return np;
        const int rel = np - 4096, tile = rel >> 8, w = rel & 255; return ((w >> 7) ? 5120 : 4096) + tile * 128 + (w & 127);
    }
    return np;
}
__device__ __forceinline__ void transpose_item(const float* W, int K, int N, bf16_t* Wt, int mode, int item, int lane, const float* kgain = nullptr, int kglim = 0, const float* kscale = nullptr, const float* sh = nullptr, float* cacc = nullptr, bf16_t* Wu = nullptr, const float* kscale_u = nullptr, const float* sh_u = nullptr, float* cacc_u = nullptr) {
    const int nblk = N / 32, kb = item / nblk, nb = item % nblk;
    const int ns = lane & 7, kg = lane >> 3, np0 = nb * 32 + 4 * ns, c0 = colmap(mode, np0), k0 = kb * 64 + 8 * kg;
    f32x4 v[8];
#pragma unroll
    for (int j = 0; j < 8; ++j) v[j] = __builtin_nontemporal_load((const f32x4*)(W + (size_t)(k0 + j) * N + c0));
    if (sh != nullptr) {
        const f32x4 s0 = *(const f32x4*)(sh + k0), s1 = *(const f32x4*)(sh + k0 + 4);
        f32x4 p = v[0] * s0[0] + v[1] * s0[1] + v[2] * s0[2] + v[3] * s0[3] + v[4] * s1[0] + v[5] * s1[1] + v[6] * s1[2] + v[7] * s1[3];
#pragma unroll
        for (int e = 0; e < 4; ++e) { float q = p[e]; q += __shfl_xor(q, 8); q += __shfl_xor(q, 16); q += __shfl_xor(q, 32); p[e] = q; }
        if (kg == 0) {
#pragma unroll
            for (int e = 0; e < 4; ++e) unsafeAtomicAdd(cacc + np0 + e, p[e]); }
    }
    if (Wu != nullptr && np0 >= 1024 && np0 < 3072) {
        { const f32x4 s0 = *(const f32x4*)(sh_u + k0), s1 = *(const f32x4*)(sh_u + k0 + 4);
          f32x4 p = v[0] * s0[0] + v[1] * s0[1] + v[2] * s0[2] + v[3] * s0[3] + v[4] * s1[0] + v[5] * s1[1] + v[6] * s1[2] + v[7] * s1[3];
#pragma unroll
          for (int e = 0; e < 4; ++e) { float q = p[e]; q += __shfl_xor(q, 8); q += __shfl_xor(q, 16); q += __shfl_xor(q, 32); p[e] = q; }
          if (kg == 0) {
#pragma unroll
              for (int e = 0; e < 4; ++e) unsafeAtomicAdd(cacc_u + np0 - 1024 + e, p[e]); } }
        const f32x4 u0 = *(const f32x4*)(kgain + k0) * (*(const f32x4*)(kscale_u + k0) + 1.0f), u1 = *(const f32x4*)(kgain + k0 + 4) * (*(const f32x4*)(kscale_u + k0 + 4) + 1.0f);
#pragma unroll
        for (int e = 0; e < 4; ++e) { u32x4 w; w.x = cvt_pk_bf16(v[0][e] * u0[0], v[1][e] * u0[1]); w.y = cvt_pk_bf16(v[2][e] * u0[2], v[3][e] * u0[3]); w.z = cvt_pk_bf16(v[4][e] * u1[0], v[5][e] * u1[1]); w.w = cvt_pk_bf16(v[6][e] * u1[2], v[7][e] * u1[3]);
            *(u32x4*)(Wu + (size_t)(np0 - 1024 + e) * K + k0) = w; } }
    if (kgain != nullptr && k0 < kglim) {
        f32x4 g0 = *(const f32x4*)(kgain + k0), g1 = *(const f32x4*)(kgain + k0 + 4);
        if (kscale != nullptr) { g0 *= (*(const f32x4*)(kscale + k0) + 1.0f); g1 *= (*(const f32x4*)(kscale + k0 + 4) + 1.0f); }
        v[0] *= g0[0]; v[1] *= g0[1]; v[2] *= g0[2]; v[3] *= g0[3]; v[4] *= g1[0]; v[5] *= g1[1]; v[6] *= g1[2]; v[7] *= g1[3];
    }
#pragma unroll
    for (int e = 0; e < 4; ++e) { u32x4 w; w.x = cvt_pk_bf16(v[0][e], v[1][e]); w.y = cvt_pk_bf16(v[2][e], v[3][e]); w.z = cvt_pk_bf16(v[4][e], v[5][e]); w.w = cvt_pk_bf16(v[6][e], v[7][e]);
        *(u32x4*)(Wt + (size_t)(np0 + e) * K + k0) = w; }
}
__device__ __forceinline__ void ada_item(const float* wada, const float* cvec, const float* cctx, float* part, int item, int lane) {
    const int ks = item / 72, cc = item % 72;
    const float sx = silu_f(cvec[ks * 64 + lane]), sc = silu_f(cctx[ks * 64 + lane]);
    f32x4 ax = {0.f, 0.f, 0.f, 0.f}, ac = {0.f, 0.f, 0.f, 0.f};
    const float* wp = wada + (size_t)(ks * 64) * NMOD + cc * 256 + 4 * lane;
#pragma unroll 16
    for (int k = 0; k < 64; ++k) { const f32x4 w = __builtin_nontemporal_load((const f32x4*)(wp + (size_t)k * NMOD));
        const float a = __builtin_bit_cast(float, __builtin_amdgcn_readlane(__builtin_bit_cast(int, sx), k)), b = __builtin_bit_cast(float, __builtin_amdgcn_readlane(__builtin_bit_cast(int, sc), k));
        ax += w * a; ac += w * b; }
    *(f32x4*)(part + (size_t)(ks * 2 + 0) * NMOD + cc * 256 + 4 * lane) = ax;
    *(f32x4*)(part + (size_t)(ks * 2 + 1) * NMOD + cc * 256 + 4 * lane) = ac;
}
__device__ __forceinline__ void norm_rows(const float* src_x, const float* src_c, int nrows, bf16_t* H, const float* g, const float* mods, int ishift, int iscale, int gw, int ngw, int lane) {
    for (int m = gw; m < nrows; m += ngw) {
        const bool isc = m >= SEQ;
        const float* src = isc ? src_c + (size_t)(m - SEQ) * DM : src_x + (size_t)m * DM; const float* md = mods + (isc ? NMOD : 0);
        f32x4 v[8]; float ss = 0.f;
#pragma unroll
        for (int j = 0; j < 8; ++j) { v[j] = __builtin_nontemporal_load((const f32x4*)(src + 4 * lane + 256 * j)); ss += (v[j][0] * v[j][0] + v[j][1] * v[j][1]) + (v[j][2] * v[j][2] + v[j][3] * v[j][3]); }
        const float rinv = __builtin_amdgcn_rsqf(wave_sum(ss) * (1.0f / DM) + EPS);
#pragma unroll
        for (int j = 0; j < 8; ++j) { const int c = 4 * lane + 256 * j;
            const f32x4 gg = *(const f32x4*)(g + c), sc = *(const f32x4*)(md + iscale * DM + c), sh = *(const f32x4*)(md + ishift * DM + c);
            const f32x4 h = v[j] * rinv * gg * (sc + 1.0f) + sh;
            u32x2 w; w.x = cvt_pk_bf16(h[0], h[1]); w.y = cvt_pk_bf16(h[2], h[3]);
            *(u32x2*)(H + (size_t)m * DM + c) = w; }
    }
}

__device__ __forceinline__ void norm_rows_b16(const bf16_t* src, int nrows, bf16_t* H, const float* g, const float* mods, int ishift, int iscale, int gw, int ngw, int lane) {
    for (int m = gw; m < nrows; m += ngw) {
        const float* md = mods + (m >= SEQ ? NMOD : 0);
        bf16x8 v[4]; float ss = 0.f;
#pragma unroll
        for (int j = 0; j < 4; ++j) { v[j] = *(const bf16x8*)(src + (size_t)m * DM + 8 * lane + 512 * j);
#pragma unroll
            for (int e = 0; e < 8; ++e) { const float f = bf2f((unsigned short)v[j][e]); ss += f * f; } }
        const float rinv = __builtin_amdgcn_rsqf(wave_sum(ss) * (1.0f / DM) + EPS);
#pragma unroll
        for (int j = 0; j < 4; ++j) { const int c = 8 * lane + 512 * j; float h[8];
#pragma unroll
            for (int q = 0; q < 2; ++q) { const f32x4 gg = *(const f32x4*)(g + c + 4 * q), sc = *(const f32x4*)(md + iscale * DM + c + 4 * q), sh = *(const f32x4*)(md + ishift * DM + c + 4 * q);
#pragma unroll
                for (int e = 0; e < 4; ++e) h[4 * q + e] = bf2f((unsigned short)v[j][4 * q + e]) * rinv * gg[e] * (sc[e] + 1.0f) + sh[e]; }
            u32x4 w; w.x = cvt_pk_bf16(h[0], h[1]); w.y = cvt_pk_bf16(h[2], h[3]); w.z = cvt_pk_bf16(h[4], h[5]); w.w = cvt_pk_bf16(h[6], h[7]);
            *(u32x4*)(H + (size_t)m * DM + c) = w; }
    }
}

__device__ __forceinline__ void attn_unit(int u, const bf16_t* Q, const bf16_t* Kb, const bf16_t* Vt, const float* rpb, bf16_t* Y, float* ssq, LAS float* tab, const LAS unsigned char* ckv, int lane) {
    const int h = u >> 9, tile = u & 511, rp = tile >> 2, cg = tile & 3;
    const int ql = lane & 31, hi = lane >> 5;
    const int r0 = 2 * rp, qr = r0 + (ql >> 4), qc = 16 * cg + (ql & 15), qtok = qr * 64 + qc;
    for (int i = lane; i < 465; i += 64) tab[64 + i] = rpb[h * 465 + i] * LOG2E;
    bf16x8 qf[4];
#pragma unroll
    for (int c = 0; c < 4; ++c) qf[c] = *(const bf16x8*)(Q + (size_t)qtok * DA + h * 64 + 16 * c + 8 * hi);
    const int rs_q = min(max(qr - 4, 0), 248), cs_q = min(max(qc - 8, 0), 48);
    const int rs0 = min(max(r0 - 4, 0), 248), rs1 = min(max(r0 - 3, 0), 248);
    const int nblk = 8 + ((rs1 != rs0) ? 9 : 8);
    const int kc0 = min(max(16 * cg - 8, 0), 32);
    const unsigned vmask = (unsigned)((0xFFFFull << (cs_q - kc0 - 8 * hi + 8)) >> 8);
    const int kap = (ql & 19) | ((ql & 4) << 1) | ((ql & 8) >> 1);
    const bf16_t* kbase = Kb + (size_t)kap * DA + h * 64 + 8 * hi;
    const bf16_t* vbase = Vt + (size_t)(h * 64 + ql) * MT + 8 * hi;
    f32x16 o0, o1;
#pragma unroll
    for (int i = 0; i < 16; ++i) { o0[i] = 0.f; o1[i] = 0.f; }
    float mrun = -1e30f, lrun = 0.f;
    asm volatile("s_waitcnt lgkmcnt(0)" ::: "memory");
    auto block = [&](const bf16x8 (&kf)[4], const bf16x8 (&vf)[4], const bool local, const int kr) __attribute__((always_inline)) {
        f32x16 s;
#pragma unroll
        for (int i = 0; i < 16; ++i) s[i] = 0.f;
#pragma unroll
        for (int c = 0; c < 4; ++c) s = __builtin_amdgcn_mfma_f32_32x32x16_bf16(kf[c], qf[c], s, 0, 0, 0);
        if (local) {
            const unsigned vmr = ((kr >= rs_q) && (kr < rs_q + 8)) ? vmask : 0u;
            const int bi = 64 + (kr - qr + 7) * 31 + (kc0 + 8 * hi - qc + 15);
            float bs[16];
#pragma unroll
            for (int i = 0; i < 16; ++i) { const int j = 16 * (i >> 3) + 4 * ((i >> 2) & 1) + (i & 3); bs[i] = tab[bi + j]; }
            asm volatile("" ::: "memory");
#pragma unroll
            for (int i = 0; i < 16; ++i) { const int j = 16 * (i >> 3) + 4 * ((i >> 2) & 1) + (i & 3);
                const float t = s[i] + bs[i];
                s[i] = ((vmr >> j) & 1u) ? t : -1e30f; }
        }
        float bm = s[0];
#pragma unroll
        for (int i = 1; i < 16; ++i) bm = fmaxf(bm, s[i]);
        bm = fmaxf(bm, __shfl_xor(bm, 32));
        if (__builtin_amdgcn_ballot_w64(bm > mrun) != 0ull) {
            const float mnew = fmaxf(mrun, bm), alpha = __builtin_amdgcn_exp2f(mrun - mnew);
            mrun = mnew; lrun *= alpha;
#pragma unroll
            for (int i = 0; i < 16; ++i) { o0[i] *= alpha; o1[i] *= alpha; } }
        float ps = 0.f;
#pragma unroll
        for (int i = 0; i < 16; ++i) { s[i] = __builtin_amdgcn_exp2f(s[i] - mrun); ps += s[i]; }
        lrun += ps;
        u32x4 p0, p1;
        p0.x = cvt_pk_bf16(s[0], s[1]); p0.y = cvt_pk_bf16(s[2], s[3]); p0.z = cvt_pk_bf16(s[4], s[5]); p0.w = cvt_pk_bf16(s[6], s[7]);
        p1.x = cvt_pk_bf16(s[8], s[9]); p1.y = cvt_pk_bf16(s[10], s[11]); p1.z = cvt_pk_bf16(s[12], s[13]); p1.w = cvt_pk_bf16(s[14], s[15]);
        const bf16x8 pb0 = __builtin_bit_cast(bf16x8, p0), pb1 = __builtin_bit_cast(bf16x8, p1);
        o0 = __builtin_amdgcn_mfma_f32_32x32x16_bf16(vf[0], pb0, o0, 0, 0, 0);
        o0 = __builtin_amdgcn_mfma_f32_32x32x16_bf16(vf[1], pb1, o0, 0, 0, 0);
        o1 = __builtin_amdgcn_mfma_f32_32x32x16_bf16(vf[2], pb0, o1, 0, 0, 0);
        o1 = __builtin_amdgcn_mfma_f32_32x32x16_bf16(vf[3], pb1, o1, 0, 0, 0);
    };
    auto ldkv = [&](bf16x8 (&k)[4], bf16x8 (&v)[4], const int L) __attribute__((always_inline)) {
        const int tok0 = (rs0 + L) * 64 + kc0;
#pragma unroll
        for (int c = 0; c < 4; ++c) k[c] = *(const bf16x8*)(kbase + (size_t)tok0 * DA + 16 * c);
#pragma unroll
        for (int d = 0; d < 2; ++d)
#pragma unroll
            for (int t = 0; t < 2; ++t) v[d * 2 + t] = *(const bf16x8*)(vbase + (size_t)(32 * d) * MT + tok0 + 16 * t);
    };
    const int nloc = nblk - 8;
    bf16x8 kA[4], vA[4], kB[4], vB[4];
    ldkv(kA, vA, 0);
    for (int b = 0; b < 8; ++b) {
        bf16x8 kf[4], vf[4];
#pragma unroll
        for (int c = 0; c < 4; ++c) kf[c] = *(const LAS bf16x8*)(ckv + ((((b * 4 + c) * 2 + hi) * 32 + ql) << 4));
#pragma unroll
        for (int d = 0; d < 2; ++d)
#pragma unroll
            for (int t = 0; t < 2; ++t) vf[d * 2 + t] = *(const LAS bf16x8*)(ckv + 32768 + ((((((b * 2 + d) * 2 + t) * 2 + hi) * 32) + ql) << 4));
        block(kf, vf, false, 0);
    }
    for (int L = 0; L < nloc; L += 2) {
        ldkv(kB, vB, min(L + 1, nloc - 1));
        block(kA, vA, true, rs0 + L);
        if (L + 1 < nloc) { ldkv(kA, vA, min(L + 2, nloc - 1)); block(kB, vB, true, rs0 + L + 1); }
    }
    const float ltot = lrun + __shfl_xor(lrun, 32), inv = 1.0f / ltot;
    float sq = 0.f;
    bf16_t* yp = Y + (size_t)qtok * DM + h * 64 + 4 * hi;
#pragma unroll
    for (int a = 0; a < 4; ++a) {
        const float x0 = o0[4 * a] * inv, x1 = o0[4 * a + 1] * inv, x2 = o0[4 * a + 2] * inv, x3 = o0[4 * a + 3] * inv;
        const float y0 = o1[4 * a] * inv, y1 = o1[4 * a + 1] * inv, y2 = o1[4 * a + 2] * inv, y3 = o1[4 * a + 3] * inv;
        sq += (x0 * x0 + x1 * x1) + (x2 * x2 + x3 * x3) + (y0 * y0 + y1 * y1) + (y2 * y2 + y3 * y3);
        u32x2 w0, w1; w0.x = cvt_pk_bf16(x0, x1); w0.y = cvt_pk_bf16(x2, x3); w1.x = cvt_pk_bf16(y0, y1); w1.y = cvt_pk_bf16(y2, y3);
        *(u32x2*)(yp + 8 * a) = w0; *(u32x2*)(yp + 32 + 8 * a) = w1;
    }
    sq += __shfl_xor(sq, 32);
    if (hi == 0) unsafeAtomicAdd(ssq + qtok, sq);
}

__device__ __forceinline__ void conv_rows(const bf16_t* BG, const bf16_t* Z, const float* cw, const float* cb, const float* gc, bf16_t* Y, int gw, int ngw, int lane) {
    f32x4 w0[2][2], w1[2][2], w2[2][2], bb[2][2], gg[2][2];
#pragma unroll
    for (int hf = 0; hf < 2; ++hf)
#pragma unroll
        for (int q4 = 0; q4 < 2; ++q4) { const int ch = 512 * hf + 8 * lane + 4 * q4;
            w0[hf][q4] = *(const f32x4*)(cw + ch); w1[hf][q4] = *(const f32x4*)(cw + DA + ch); w2[hf][q4] = *(const f32x4*)(cw + 2 * DA + ch); bb[hf][q4] = *(const f32x4*)(cb + ch); gg[hf][q4] = *(const f32x4*)(gc + ch); }
    const bf16x8 zero8 = {0, 0, 0, 0, 0, 0, 0, 0};
    for (int t0 = gw * 8; t0 < SEQ; t0 += ngw * 8) {
        bf16x8 zp[2], zc[2], zn[2];
#pragma unroll
        for (int hf = 0; hf < 2; ++hf) { const int ch = 512 * hf + 8 * lane;
            zp[hf] = (t0 > 0) ? *(const bf16x8*)(Z + (size_t)(t0 - 1) * DA + ch) : zero8; zc[hf] = *(const bf16x8*)(Z + (size_t)t0 * DA + ch); }
#pragma unroll
        for (int i = 0; i < 8; ++i) { const int t = t0 + i;
            float val[16]; float ss = 0.f;
#pragma unroll
            for (int hf = 0; hf < 2; ++hf) { const int ch = 512 * hf + 8 * lane;
                zn[hf] = (t < SEQ - 1) ? *(const bf16x8*)(Z + (size_t)(t + 1) * DA + ch) : zero8;
                const bf16x8 bg = *(const bf16x8*)(BG + (size_t)t * DA + ch);
#pragma unroll
                for (int q4 = 0; q4 < 2; ++q4)
#pragma unroll
                    for (int e = 0; e < 4; ++e) { const int k = 4 * q4 + e;
                        const float y = bb[hf][q4][e] + w0[hf][q4][e] * bf2f((unsigned short)zp[hf][k]) + w1[hf][q4][e] * bf2f((unsigned short)zc[hf][k]) + w2[hf][q4][e] * bf2f((unsigned short)zn[hf][k]);
                        const float cv = bf2f((unsigned short)bg[k]) * y; val[8 * hf + k] = cv; ss += cv * cv; }
            }
            const float rinv = __builtin_amdgcn_rsqf(wave_sum(ss) * (1.0f / DA) + EPS);
#pragma unroll
            for (int hf = 0; hf < 2; ++hf) { const int ch = 512 * hf + 8 * lane;
                const f32x4 g0 = gg[hf][0], g1 = gg[hf][1];
                u32x4 w; w.x = cvt_pk_bf16(val[8 * hf + 0] * rinv * g0[0], val[8 * hf + 1] * rinv * g0[1]); w.y = cvt_pk_bf16(val[8 * hf + 2] * rinv * g0[2], val[8 * hf + 3] * rinv * g0[3]);
                w.z = cvt_pk_bf16(val[8 * hf + 4] * rinv * g1[0], val[8 * hf + 5] * rinv * g1[1]); w.w = cvt_pk_bf16(val[8 * hf + 6] * rinv * g1[2], val[8 * hf + 7] * rinv * g1[3]);
                *(u32x4*)(Y + (size_t)t * DM + DA + ch) = w;
                zp[hf] = zc[hf]; zc[hf] = zn[hf]; }
        }
    }
}
__device__ __forceinline__ void ynorm_rows(bf16_t* Y, const float* ssq, const float* ga, int gw, int ngw, int lane) {
    for (int t = gw; t < SEQ; t += ngw) {
        const float part = lane < NH ? ssq[lane * SEQ + t] : 0.f;
        const float rinv = __builtin_amdgcn_rsqf(wave_sum(part) * (1.0f / DA) + EPS);
#pragma unroll
        for (int hf = 0; hf < 2; ++hf) {
            const int ch = 512 * hf + 8 * lane;
            const bf16x8 a = *(const bf16x8*)(Y + (size_t)t * DM + ch);
            const f32x4 g0 = *(const f32x4*)(ga + ch), g1 = *(const f32x4*)(ga + ch + 4);
            u32x4 w; w.x = cvt_pk_bf16(bf2f((unsigned short)a[0]) * rinv * g0[0], bf2f((unsigned short)a[1]) * rinv * g0[1]); w.y = cvt_pk_bf16(bf2f((unsigned short)a[2]) * rinv * g0[2], bf2f((unsigned short)a[3]) * rinv * g0[3]);
            w.z = cvt_pk_bf16(bf2f((unsigned short)a[4]) * rinv * g1[0], bf2f((unsigned short)a[5]) * rinv * g1[1]); w.w = cvt_pk_bf16(bf2f((unsigned short)a[6]) * rinv * g1[2], bf2f((unsigned short)a[7]) * rinv * g1[3]);
            *(u32x4*)(Y + (size_t)t * DM + ch) = w;
        }
    }
}


template <class Fin>
__device__ __forceinline__ void wg_gemm64(const bf16_t* act, const bf16_t* w0, const bf16_t* w1, const int K, LAS unsigned char* lds, int wave, int lane, const Fin& fin) {
    const int ql = lane & 31, hi = lane >> 5;
    const int kw = K >> 3;
    unsigned voff[2];
    const int r16 = lane >> 2, g4 = lane & 3;
#pragma unroll
    for (int i = 0; i < 2; ++i) voff[i] = (unsigned)((16 * i + r16) * K + 8 * g4) * 2u;
    const char* gp0 = (const char*)(act + wave * kw); const char* gp1 = (const char*)(act + (size_t)32 * K + wave * kw); const char* gp2 = (const char*)(w0 + wave * kw); const char* gp3 = (const char*)(w1 + wave * kw);
    LAS unsigned char* wl = lds + wave * 16384;
    const int woff = r16 * 64 + ((g4 ^ ((r16 >> 1) & 3)) << 4);
    const int roff = ql * 64;
    f32x16 acc[2][2];
#pragma unroll
    for (int cb = 0; cb < 2; ++cb)
#pragma unroll
        for (int rb = 0; rb < 2; ++rb)
#pragma unroll
            for (int i = 0; i < 16; ++i) acc[cb][rb][i] = 0.f;
    bf16x8 st[4][2];
#pragma unroll
    for (int i = 0; i < 2; ++i) { st[0][i] = *(const bf16x8*)(gp0 + voff[i]); st[1][i] = *(const bf16x8*)(gp1 + voff[i]); st[2][i] = *(const bf16x8*)(gp2 + voff[i]); st[3][i] = *(const bf16x8*)(gp3 + voff[i]); }
    for (int k = 0; k < kw; k += 32) {
#pragma unroll
        for (int b4 = 0; b4 < 4; ++b4)
#pragma unroll
            for (int i = 0; i < 2; ++i) *(LAS bf16x8*)(wl + (b4 * 32 + 16 * i) * 64 + woff) = st[b4][i];
        asm volatile("" ::: "memory");
        if (k + 32 < kw) {
#pragma unroll
            for (int i = 0; i < 2; ++i) { const size_t ko = (size_t)(k + 32) * 2; st[0][i] = *(const bf16x8*)(gp0 + ko + voff[i]); st[1][i] = *(const bf16x8*)(gp1 + ko + voff[i]); st[2][i] = *(const bf16x8*)(gp2 + ko + voff[i]); st[3][i] = *(const bf16x8*)(gp3 + ko + voff[i]); }
        }
#pragma unroll
        for (int sub = 0; sub < 2; ++sub) {
            const int go = ((2 * sub + hi) ^ ((ql >> 1) & 3)) << 4;
            const bf16x8 a0 = *(const LAS bf16x8*)(wl + roff + go), a1 = *(const LAS bf16x8*)(wl + 2048 + roff + go), b0 = *(const LAS bf16x8*)(wl + 4096 + roff + go), b1 = *(const LAS bf16x8*)(wl + 6144 + roff + go);
            acc[0][0] = __builtin_amdgcn_mfma_f32_32x32x16_bf16(b0, a0, acc[0][0], 0, 0, 0);
            acc[0][1] = __builtin_amdgcn_mfma_f32_32x32x16_bf16(b0, a1, acc[0][1], 0, 0, 0);
            acc[1][0] = __builtin_amdgcn_mfma_f32_32x32x16_bf16(b1, a0, acc[1][0], 0, 0, 0);
            acc[1][1] = __builtin_amdgcn_mfma_f32_32x32x16_bf16(b1, a1, acc[1][1], 0, 0, 0);
        }
        asm volatile("" ::: "memory");
    }
#pragma unroll
    for (int cb = 0; cb < 2; ++cb)
#pragma unroll
        for (int rb = 0; rb < 2; ++rb)
#pragma unroll
            for (int ig = 0; ig < 4; ++ig) { const int row = 32 * rb + ql, g = 8 * cb + 2 * ig + hi;
                *(LAS f32x4*)(lds + (((wave * 64 + row) * 16 + (g ^ (row & 15))) << 4)) = (f32x4){acc[cb][rb][4 * ig], acc[cb][rb][4 * ig + 1], acc[cb][rb][4 * ig + 2], acc[cb][rb][4 * ig + 3]}; }
    __syncthreads();
    const int c = ql, hh = hi;
#pragma unroll
    for (int j = 0; j < 4; ++j) { const int r = wave * 8 + hh * 4 + j;
        float va = 0.f, vb = 0.f;
#pragma unroll
        for (int w = 0; w < 8; ++w) {
            va += *(const LAS float*)(lds + ((((w * 64 + r) * 16 + ((c >> 2) ^ (r & 15))) << 4) + ((c & 3) << 2)));
            vb += *(const LAS float*)(lds + ((((w * 64 + r) * 16 + ((8 + (c >> 2)) ^ (r & 15))) << 4) + ((c & 3) << 2))); }
        fin(r, c, va, vb); }
    __syncthreads();
}

#define XB_TMO      128
#define XB_XCNT(j)  (256  + 64 * (j))
#define XB_XSUB(j)  (1280 + 64 * (j))
#define XB_XGEN(j)  (2304 + 64 * (j))
#define XB_TOP      3328
#define XB_TOPGEN   3392
#define XCD_BAR_WORDS 3456
#define XB_SPIN_CAP (1u << 18)
__device__ __forceinline__ unsigned xb_ld(unsigned* p)              { return __hip_atomic_load(p, __ATOMIC_RELAXED, __HIP_MEMORY_SCOPE_AGENT); }
__device__ __forceinline__ unsigned xb_add(unsigned* p, unsigned v) { return __hip_atomic_fetch_add(p, v, __ATOMIC_RELAXED, __HIP_MEMORY_SCOPE_AGENT); }
__device__ __forceinline__ unsigned xb_xcc_id() { return (unsigned)__builtin_amdgcn_s_getreg((3 << 11) | 20) & 0xFu; }
#define XB_SPIN(cond, bar) do { unsigned _sp = 0; while (cond) { __builtin_amdgcn_s_sleep(1); \
    if ((++_sp & 255u) == 0u) { if (xb_ld(&(bar)[XB_TMO])) break; if (_sp > XB_SPIN_CAP) { atomicAdd(&(bar)[XB_TMO], 1u); break; } } } } while (0)
struct XcdBarrier { unsigned* bar; unsigned x; volatile LAS unsigned* st; };
__device__ __forceinline__ XcdBarrier xcd_barrier_post(unsigned* bar, volatile LAS unsigned* st) {
    XcdBarrier b; b.bar = bar; b.x = xb_xcc_id(); b.st = st;
    if (threadIdx.x == 0) (void)xb_add(&bar[XB_XCNT(b.x)], 1u);
    return b;
}
__device__ __forceinline__ void xcd_barrier_complete(unsigned* bar, unsigned x, unsigned& nloc, unsigned& nx) {
    const unsigned G = gridDim.x * gridDim.y * gridDim.z;
    unsigned sum, cnt, mine, sp = 0u;
    for (;;) {
        sum = 0u; cnt = 0u; mine = 0u;
#pragma unroll
        for (unsigned j = 0; j < 16; ++j) { const unsigned c = xb_ld(&bar[XB_XCNT(j)]); sum += c; cnt += (c > 0u) ? 1u : 0u; mine = (j == x) ? c : mine; }
        if (sum == G) break;
        __builtin_amdgcn_s_sleep(1);
        if ((++sp & 255u) == 0u) { if (xb_ld(&bar[XB_TMO])) break; if (sp > XB_SPIN_CAP) { atomicAdd(&bar[XB_TMO], 1u); break; } }
    }
    nloc = mine > 0u ? mine : 1u; nx = cnt > 0u ? cnt : 1u;
}
__device__ __forceinline__ void xcd_barrier(const XcdBarrier& b) {
    asm volatile("s_waitcnt vmcnt(0)" ::: "memory");
    __syncthreads();
    if (threadIdx.x == 0) {
        unsigned* bar = b.bar;
        __builtin_amdgcn_s_waitcnt(0);
        unsigned nloc = b.st[0], nx = b.st[1];
        if (nloc == 0u) { xcd_barrier_complete(bar, b.x, nloc, nx); b.st[0] = nloc; b.st[1] = nx; }
        const unsigned old = xb_add(&bar[XB_XSUB(b.x)], 1u);
        const unsigned gen = old / nloc;
        if (old + 1u == (gen + 1u) * nloc) {
            __builtin_amdgcn_fence(__ATOMIC_RELEASE, "agent");
            asm volatile("s_waitcnt vmcnt(0)" ::: "memory");
            const unsigned og = xb_add(&bar[XB_TOP], 1u);
            const unsigned tg = og / nx;
            if (og + 1u == (tg + 1u) * nx) xb_add(&bar[XB_TOPGEN], 1u);
            else XB_SPIN(xb_ld(&bar[XB_TOPGEN]) == tg, bar);
            __builtin_amdgcn_fence(__ATOMIC_ACQUIRE, "agent");
            xb_add(&bar[XB_XGEN(b.x)], 1u);
            asm volatile("s_waitcnt vmcnt(0)" ::: "memory");
        } else {
            XB_SPIN(xb_ld(&bar[XB_XGEN(b.x)]) == gen, bar);
            __builtin_amdgcn_fence(__ATOMIC_ACQUIRE, "agent");
            asm volatile("s_waitcnt vmcnt(0)" ::: "memory");
        }
    }
    __syncthreads();
}

constexpr int NPHASE = 13;
constexpr int LDS_BYTES = 147456;
struct Args { const float* in[22]; float* out; unsigned char* ws; int ph_lo, ph_hi; };

__global__ void __launch_bounds__(512, 2) fwd(Args a) {
    extern __shared__ __attribute__((aligned(16))) unsigned char lds_raw[];
    LAS unsigned char* lds = (LAS unsigned char*)lds_raw;
    const int tid = threadIdx.x, lane = tid & 63, wave = __builtin_amdgcn_readfirstlane(tid >> 6);
    const int G = gridDim.x, bx = blockIdx.x;
    const int vcu = (G % 8 == 0) ? (bx % 8) * (G / 8) + bx / 8 : bx;
    const int gw = vcu * 8 + wave, ngw = G * 8;
    unsigned char* ws = a.ws;
    const float *x = a.in[0], *cvec = a.in[1], *ctx = a.in[2], *cctx = a.in[3], *wada = a.in[4], *bada = a.in[5], *ff1n = a.in[6], *ff1wi = a.in[7], *ff1wo = a.in[8],
                *mixn = a.in[9], *win = a.in[10], *qn = a.in[11], *kn = a.in[12], *rpb = a.in[13], *convw = a.in[14], *convb = a.in[15], *ona = a.in[16], *onc = a.in[17],
                *wout = a.in[18], *ff2n = a.in[19], *ff2wi = a.in[20], *ff2wo = a.in[21];
    float* mods = (float*)(ws + WS_MODS); float* ropec = (float*)(ws + WS_ROPE); float* ropes = ropec + 256 * 16; float* mpart = (float*)(ws + WS_MPART); float* ssq = (float*)(ws + WS_SSQ);
    bf16_t *Wt1 = (bf16_t*)(ws + WS_WT1), *Wt2 = (bf16_t*)(ws + WS_WT2), *Wt3 = (bf16_t*)(ws + WS_WT3), *Wt4 = (bf16_t*)(ws + WS_WT4), *Wt5 = (bf16_t*)(ws + WS_WT5), *Wt6 = (bf16_t*)(ws + WS_WT6);
    bf16_t *H = (bf16_t*)(ws + WS_H), *Gb = (bf16_t*)(ws + WS_G), *Qb = (bf16_t*)(ws + WS_Q), *Kb = (bf16_t*)(ws + WS_K), *Vt = (bf16_t*)(ws + WS_VT), *BG = (bf16_t*)(ws + WS_BG), *Zb = (bf16_t*)(ws + WS_Z);
    bf16_t* X1b = (bf16_t*)(ws + WS_X1); float* ssq1 = (float*)(ws + WS_SSQ1); float* c3 = (float*)(ws + WS_C3); float* c3c = (float*)(ws + WS_C3C); bf16_t* Wt3u = (bf16_t*)(ws + WS_WT3U); float* ssq2 = (float*)(ws + WS_SSQ2); float* c5 = (float*)(ws + WS_C5);
    const int lo = a.ph_lo, hi = a.ph_hi;
    volatile LAS unsigned* MISC = (volatile LAS unsigned*)(lds + 131072 + 320);
    if (tid < 32) MISC[tid] = 0u;
    __syncthreads();
    unsigned* barw = (unsigned*)(ws + WS_BAR);
    XcdBarrier bar; bar.bar = barw; bar.x = 0; bar.st = MISC + 8;
    if (MK_N_LAUNCHES == 1) bar = xcd_barrier_post(barw, MISC + 8);
#define IN(k) (lo <= (k) && (k) < hi)
#define SEAM(k) do { if (IN(k) && IN((k) + 1)) xcd_barrier(bar); } while (0)

    TP_START(0);
    if (IN(0)) for (int rep = 0; rep < REP(0); ++rep) {
        constexpr int I_ADA = KSPLIT * 72, I_1 = (DM / 64) * (FF2 / 32), I_2 = (FF / 64) * (DM / 32);
        constexpr int NIT = I_ADA + I_1 + I_2;
        for (int it = gw; it < NIT; it += ngw) {
            int r = it;
            if (r < I_ADA) { ada_item(wada, cvec, cctx, mpart, r, lane); continue; } r -= I_ADA;
            if (r < I_1) { transpose_item(ff1wi, DM, FF2, Wt1, 1, r, lane); continue; } r -= I_1;
            transpose_item(ff1wo, FF, DM, Wt2, 0, r, lane);
        }
    }
    if (a.ph_lo < 0) __ockl_grid_sync();
    SEAM(0);
    TP_END(0);
    TP_START(1);
    if (IN(1)) for (int rep = 0; rep < REP(1); ++rep) {
        const int gt = bx * 512 + tid;
        if (gt < 2 * NMOD / 4) { const int v = gt / (NMOD / 4), j = (gt % (NMOD / 4)) * 4;
            f32x4 s = *(const f32x4*)(bada + j);
            for (int ks = 0; ks < KSPLIT; ++ks) s += *(const f32x4*)(mpart + (size_t)(ks * 2 + v) * NMOD + j);
            *(f32x4*)(mods + v * NMOD + j) = s; }
        else if (gt < 2 * NMOD / 4 + 4096) { const int idx = gt - 2 * NMOD / 4, pos = idx >> 4, i = idx & 15;
            const int i3 = i & 3; const float base4 = i3 == 0 ? 1.0f : i3 == 1 ? 0.5623413251903491f : i3 == 2 ? 0.31622776601683794f : 0.1778279410038923f;
            const int i2 = i >> 2; const float dec = i2 == 0 ? 1.0f : i2 == 1 ? 0.1f : i2 == 2 ? 0.01f : 0.001f;
            const float inv = base4 * dec;
            const float angf = (float)pos * inv;
            const double ang = (double)angf;
            const double r = ang - 6.283185307179586 * __builtin_rint(ang * 0.15915494309189535);
            const double r2 = r * r; double sn = r, cs = 1.0, ts = r, tc = 1.0;
#pragma unroll
            for (int k = 1; k <= 12; ++k) { tc = -tc * r2 / (double)((2 * k - 1) * (2 * k)); cs += tc; ts = -ts * r2 / (double)((2 * k) * (2 * k + 1)); sn += ts; }
            ropec[idx] = (float)cs; ropes[idx] = (float)sn; }
        else if (gt < 2 * NMOD / 4 + 4096 + SEQ / 4) { *(f32x4*)(ssq2 + 4 * (gt - (2 * NMOD / 4 + 4096))) = (f32x4){0.f, 0.f, 0.f, 0.f}; }
        else if (gt < 2 * NMOD / 4 + 4096 + 2 * (SEQ / 4)) { *(f32x4*)(ssq + 4 * (gt - (2 * NMOD / 4 + 4096 + SEQ / 4))) = (f32x4){0.f, 0.f, 0.f, 0.f}; }
        else if (gt >= 60000 && gt < 60000 + DM / 4) { *(f32x4*)(c3c + 4 * (gt - 60000)) = (f32x4){0.f, 0.f, 0.f, 0.f}; }
        else if (gt >= 40000 && gt < 40000 + MT / 4) { *(f32x4*)(ssq1 + 4 * (gt - 40000)) = (f32x4){0.f, 0.f, 0.f, 0.f}; }
        else if (gt >= 50000 && gt < 50000 + DIN / 4) { *(f32x4*)(c3 + 4 * (gt - 50000)) = (f32x4){0.f, 0.f, 0.f, 0.f}; }
        else if (gt < 2 * NMOD / 4 + 4096 + 2 * (SEQ / 4) + FF2 / 4) { *(f32x4*)(c5 + 4 * (gt - (2 * NMOD / 4 + 4096 + 2 * (SEQ / 4)))) = (f32x4){0.f, 0.f, 0.f, 0.f}; }
    }
    SEAM(1);
    TP_END(1);
    TP_START(2);
    if (IN(2)) { norm_rows(x, ctx, MT, H, ff1n, mods, 0, 1, gw, ngw, lane);
        for (int it = gw; it < (DM / 64) * (DIN / 32); it += ngw) transpose_item(win, DM, DIN, Wt3, 3, it, lane, mixn, DM, mods + 4 * DM, mods + 3 * DM, c3, Wt3u, mods + NMOD + 4 * DM, mods + NMOD + 3 * DM, c3c);
        { constexpr int J_1 = (DM / 64) * (FF2 / 32), J_2 = (FF / 64) * (DM / 32), J_4 = (DM / 64) * (DM / 32), NJ = J_4 + J_1 + J_2;
          for (int ti = gw; ti < NJ; ti += ngw) { int r = ti;
              if (r < J_4) transpose_item(wout, DM, DM, Wt4, 0, r, lane, ona, DA);
              else if ((r -= J_4) < J_1) transpose_item(ff2wi, DM, FF2, Wt5, 1, r, lane, ff2n, DM, mods + 7 * DM, mods + 6 * DM, c5);
              else transpose_item(ff2wo, FF, DM, Wt6, 0, r - J_1, lane); } } }
    SEAM(2);
    TP_END(2);
    TP_START(3);
    if (IN(3)) {
#define P3_CTX() for (int u = vcu; u < 4 * 176; u += G) { const int rb2 = u & 3, jb = u >> 2, tile = jb >> 2, wq = (jb & 3) * 32; \
            const bf16_t* w0 = Wt1 + (size_t)(256 * tile + wq) * DM; \
            bf16_t* gp = Gb + (size_t)(SEQ + 64 * rb2) * FF + 32 * jb; \
            wg_gemm64(H + (size_t)(SEQ + 64 * rb2) * DM, w0, w0 + (size_t)128 * DM, DM, lds, wave, lane, \
                      [&](int r, int c, float va, float vb) { gp[(size_t)r * FF + c] = (bf16_t)(cvt_pk_bf16(silu_f(va) * vb, 0.f) & 0xffffu); }); }
        if (bx & 1) { P3_CTX() }
        { GSched S{(const char*)H, (const char*)Wt1, DM, 64, 44, 0, 0, G, bx}; EpiSwiGLU<false> E{Gb, nullptr, nullptr}; pg8::gemm_phase(lds, DM, S, E); }
        if (!(bx & 1)) { P3_CTX() }
#undef P3_CTX
    }
    SEAM(3);
    TP_END(3);
    TP_START(4);
    if (IN(4)) {
        for (int u = vcu; u < 4 * 32; u += G) { const int rb2 = u & 3, cb2 = u >> 2;
            const bf16_t* w0 = Wt2 + (size_t)(64 * cb2) * FF;
            const float* bp = ctx + (size_t)(64 * rb2) * DM + 64 * cb2; bf16_t* op = X1b + (size_t)(SEQ + 64 * rb2) * DM + 64 * cb2; const float* gp = mods + NMOD + 2 * DM + 64 * cb2;
            wg_gemm64(Gb + (size_t)(SEQ + 64 * rb2) * FF, w0, w0 + (size_t)32 * FF, FF, lds, wave, lane,
                      [&](int r, int c, float va, float vb) { const float xa = bp[(size_t)r * DM + c] + 0.5f * gp[c] * va, xb = bp[(size_t)r * DM + c + 32] + 0.5f * gp[c + 32] * vb;
                          op[(size_t)r * DM + c] = (bf16_t)(cvt_pk_bf16(xa, 0.f) & 0xffffu); op[(size_t)r * DM + c + 32] = (bf16_t)(cvt_pk_bf16(xb, 0.f) & 0xffffu);
                          float ss = xa * xa + xb * xb;
#pragma unroll
                          for (int o = 1; o < 32; o <<= 1) ss += __shfl_xor(ss, o);
                          if (c == 0) unsafeAtomicAdd(ssq1 + SEQ + 64 * rb2 + r, ss); }); }
        GSched S{(const char*)Gb, (const char*)Wt2, FF, 64, 8, 0, 0, G, bx}; EpiResid<true, false, false, true> E{x, X1b, mods + 2 * DM, 0.5f, ssq1, nullptr}; pg8::gemm_phase(lds, FF, S, E); }
    SEAM(4);
    TP_END(4);
    TP_START(6);
    if (IN(6)) {
        for (int u = vcu; u < 128; u += G) {
            if (u < 64) { const int rb2 = u & 3, hd = u >> 2;
                const bf16_t* w0 = Wt3u + (size_t)(256 * (hd >> 2) + 32 * (hd & 3)) * DM;
                bf16_t* kp = Kb + (size_t)(SEQ + 64 * rb2) * DA + 64 * hd;
                const int nb = 256 * (hd >> 2) + 32 * (hd & 3);
                wg_gemm64(X1b + (size_t)(SEQ + 64 * rb2) * DM, w0, w0 + (size_t)128 * DM, DM, lds, wave, lane,
                          [&](int r, int c, float va, float vb) { const float ri = __builtin_amdgcn_rsqf(ssq1[SEQ + 64 * rb2 + r] * (1.0f / DM) + EPS);
                              va = va * ri + c3c[nb + c]; vb = vb * ri + c3c[nb + 128 + c];
                              float ss = va * va + vb * vb;
#pragma unroll
                              for (int o = 1; o < 32; o <<= 1) ss += __shfl_xor(ss, o);
                              const float rinv = __builtin_amdgcn_rsqf(ss * (1.0f / 64.0f) + EPS); const int d = 16 * ((c >> 2) & 1) + 4 * (c >> 3) + (c & 3);
                              kp[(size_t)r * DA + d] = (bf16_t)(cvt_pk_bf16(va * rinv * kn[d], 0.f) & 0xffffu); kp[(size_t)r * DA + d + 32] = (bf16_t)(cvt_pk_bf16(vb * rinv * kn[d + 32], 0.f) & 0xffffu); }); }
            else { const int v = u - 64, hb = v >> 2, tb = v & 3;
                const bf16_t* w0 = X1b + (size_t)(SEQ + 64 * tb) * DM;
                bf16_t* vp = Vt + (size_t)(64 * hb) * MT + SEQ + 64 * tb;
                wg_gemm64(Wt3u + (size_t)(1024 + 64 * hb) * DM, w0, w0 + (size_t)32 * DM, DM, lds, wave, lane,
                          [&](int r, int c, float va, float vb) { const float cr = c3c[1024 + 64 * hb + r];
                              va = va * __builtin_amdgcn_rsqf(ssq1[SEQ + 64 * tb + c] * (1.0f / DM) + EPS) + cr; vb = vb * __builtin_amdgcn_rsqf(ssq1[SEQ + 64 * tb + c + 32] * (1.0f / DM) + EPS) + cr;
                              vp[(size_t)r * MT + c] = (bf16_t)(cvt_pk_bf16(va, 0.f) & 0xffffu); vp[(size_t)r * MT + c + 32] = (bf16_t)(cvt_pk_bf16(vb, 0.f) & 0xffffu); }); }
        }
        GSched S{(const char*)X1b, (const char*)Wt3, DM, 64, 20, 4 * 64, 3, G, bx}; EpiInProj E{Qb, Kb, Vt, BG, Zb, qn, kn, ropec, ropes, ssq1, c3}; pg8::gemm_phase(lds, DM, S, E); }
    SEAM(6);
    TP_END(6);
    TP_START(7);
    if (IN(7)) for (int rep = 0; rep < REP(7); ++rep) {
        LAS float* tab = (LAS float*)(lds + wave * 4096);
        constexpr int J_1 = (DM / 64) * (FF2 / 32), J_2 = (FF / 64) * (DM / 32), J_4 = (DM / 64) * (DM / 32), NJ = J_4 + J_1 + J_2;
        int ti = 1 << 30;
#define P7_ITEM() do { int r = ti; if (r < J_4) transpose_item(wout, DM, DM, Wt4, 0, r, lane, ona, DA); else if ((r -= J_4) < J_1) transpose_item(ff2wi, DM, FF2, Wt5, 1, r, lane, ff2n, DM, mods + 7 * DM, mods + 6 * DM, c5); else transpose_item(ff2wo, FF, DM, Wt6, 0, r - J_1, lane); ti += ngw; } while (0)
        const int upw = (NH * 512) / ngw;
        if (upw * ngw == NH * 512 && (8 * upw) <= 512 && 512 % (8 * upw) == 0) {
            const int hcu = (vcu * 8 * upw) >> 9;
            LAS unsigned char* ckv = lds + 32768;
            for (int j = 0; j < 4; ++j) { const int gi = tid + 512 * j;
                { const int key = gi >> 3, cg = gi & 7, kk = key & 31, m = (kk & 19) | ((kk & 4) << 1) | ((kk & 8) >> 1);
                  *(LAS bf16x8*)(ckv + (((((key >> 5) * 4 + (cg >> 1)) * 2 + (cg & 1)) * 32 + m) << 4)) = *(const bf16x8*)(Kb + (size_t)(SEQ + key) * DA + hcu * 64 + 8 * cg); }
                { const int d = gi >> 5, tg = gi & 31;
                  *(LAS bf16x8*)(ckv + 32768 + (((((((tg >> 2) * 2 + (d >> 5)) * 2 + ((tg >> 1) & 1)) * 2 + (tg & 1)) * 32) + (d & 31)) << 4)) = *(const bf16x8*)(Vt + (size_t)(hcu * 64 + d) * MT + SEQ + 8 * tg); } }
            __syncthreads();
            for (int i = 0; i < upw; ++i) { attn_unit(gw * upw + i, Qb, Kb, Vt, rpb, H, ssq, tab, ckv, lane);
                for (int q = 0; q < 3 && ti < NJ; ++q) P7_ITEM(); }
            __syncthreads();
        }
        while (ti < NJ) P7_ITEM();
#undef P7_ITEM
        conv_rows(BG, Zb, convw, convb, onc, H, gw, ngw, lane);
    }
    SEAM(7);
    TP_END(7);
    TP_START(9);
    if (IN(9)) for (int rep = 0; rep < REP(9); ++rep) { GSched S{(const char*)H, (const char*)Wt4, DM, 64, 8, 0, 0, G, bx}; EpiResid<true, true, true, true> E{X1b, X1b, mods + 5 * DM, 1.0f, ssq2, ssq}; pg8::gemm_phase(lds, DM, S, E); }
    SEAM(9);
    TP_END(9);
    TP_START(10);
    if (IN(10)) { }
    TP_END(10);
    TP_START(11);
    if (IN(11)) for (int rep = 0; rep < REP(11); ++rep) { GSched S{(const char*)X1b, (const char*)Wt5, DM, 64, 44, 0, 0, G, bx}; EpiSwiGLU<true> E{Gb, ssq2, c5}; pg8::gemm_phase(lds, DM, S, E); }
    SEAM(11);
    TP_END(11);
    TP_START(12);
    if (IN(12)) for (int rep = 0; rep < REP(12); ++rep) { GSched S{(const char*)Gb, (const char*)Wt6, FF, 64, 8, 0, 0, G, bx}; EpiResid<false, false, true, false> E{X1b, a.out, mods + 8 * DM, 0.5f, nullptr, nullptr}; pg8::gemm_phase(lds, FF, S, E); }
    TP_END(12);
#ifdef TPROBE_LO
    if (bx == 0 && tid == 0) { const unsigned long long t0_ = ((unsigned long long)MISC[17] << 32) | MISC[16], t1_ = ((unsigned long long)MISC[19] << 32) | MISC[18];
        const unsigned long long d_ = (t1_ - t0_) * TPROBE_MUL, s_ = __builtin_amdgcn_s_memrealtime();
        while (__builtin_amdgcn_s_memrealtime() - s_ < d_) __builtin_amdgcn_s_sleep(8); }
#endif
#undef IN
#undef SEAM
}

extern "C" void kernel_launch(void* const* d_in, const int* in_sizes, int n_in, void* d_out, int out_size, void* d_ws, size_t ws_size, hipStream_t stream) {
    static int grid = 0;
    if (grid == 0) {
        if (n_in != 22 || out_size != SEQ * DM || ws_size < WS_END) { fprintf(stderr, "kernel_launch: unexpected shapes (n_in %d out %d ws %zu)\n", n_in, out_size, ws_size); grid = -1; return; }
        int dev = 0, cus = 0, per_cu = 0;
        if (hipGetDevice(&dev) != hipSuccess || hipDeviceGetAttribute(&cus, hipDeviceAttributeMultiprocessorCount, dev) != hipSuccess) { grid = -1; return; }
        if (hipFuncSetAttribute((const void*)fwd, hipFuncAttributeMaxDynamicSharedMemorySize, LDS_BYTES) != hipSuccess) { fprintf(stderr, "kernel_launch: hipFuncSetAttribute failed\n"); grid = -1; return; }
        if (hipOccupancyMaxActiveBlocksPerMultiprocessor(&per_cu, (const void*)fwd, 512, LDS_BYTES) != hipSuccess || per_cu < 1) { fprintf(stderr, "kernel_launch: occupancy query says %d\n", per_cu); per_cu = 1; }
        (void)hipGetLastError();
        grid = cus;
    }
    if (grid < 0) return;
    Args a{};
    for (int i = 0; i < 22; ++i) a.in[i] = (const float*)d_in[i];
    a.out = (float*)d_out; a.ws = (unsigned char*)d_ws;
    if (MK_N_LAUNCHES == 1) {
        a.ph_lo = 0; a.ph_hi = NPHASE;
        if (hipMemsetAsync((char*)d_ws + WS_BAR, 0, XCD_BAR_WORDS * 4, stream) != hipSuccess) { fprintf(stderr, "kernel_launch: hipMemsetAsync failed\n"); return; }
        void* args[] = {&a};
        hipError_t e = hipLaunchCooperativeKernel((const void*)fwd, dim3(grid), dim3(512), args, LDS_BYTES, stream);
        if (e != hipSuccess) fprintf(stderr, "cooperative launch failed: %s (grid %d)\n", hipGetErrorString(e), grid);
    } else {
        for (int p = 0; p < NPHASE; ++p) { a.ph_lo = p; a.ph_hi = p + 1; hipLaunchKernelGGL(fwd, dim3(grid), dim3(512), LDS_BYTES, stream, a); }
    }
}
```

```cpp
#include <hip/hip_runtime.h>
#include <cstdio>
#include <cstdint>

#define LAS __attribute__((address_space(3)))
typedef unsigned short bf16_t;
typedef short bf16x8 __attribute__((ext_vector_type(8)));
typedef float f32x4 __attribute__((ext_vector_type(4)));
typedef float f32x16 __attribute__((ext_vector_type(16)));
typedef unsigned u32x4 __attribute__((ext_vector_type(4)));
typedef unsigned u32x2 __attribute__((ext_vector_type(2)));

#ifdef TPROBE_LO
#define TP_START(k) do { if ((k) == TPROBE_LO && bx == 0 && tid == 0) { const unsigned long long t_ = __builtin_amdgcn_s_memrealtime(); MISC[16] = (unsigned)t_; MISC[17] = (unsigned)(t_ >> 32); } } while (0)
#define TP_END(k) do { if ((k) == TPROBE_HI && bx == 0 && tid == 0) { const unsigned long long t_ = __builtin_amdgcn_s_memrealtime(); MISC[18] = (unsigned)t_; MISC[19] = (unsigned)(t_ >> 32); } } while (0)
#else
#define TP_START(k) do {} while (0)
#define TP_END(k) do {} while (0)
#endif
#ifndef PROBE_MASK
#define PROBE_MASK 0
#endif
#define REP(k) ((((PROBE_MASK) >> (k)) & 1) ? 2 : 1)
#ifndef MK_N_LAUNCHES
#define MK_N_LAUNCHES 1
#endif

constexpr int SEQ = 16384, CTX = 256, MT = SEQ + CTX, DM = 2048, FF = 5632, FF2 = 2 * FF, DIN = 6144, DA = 1024, NH = 16;
constexpr int NMOD = 9 * DM;
constexpr float EPS = 1e-6f, LOG2E = 1.4426950408889634f;
constexpr int KSPLIT = 32;

constexpr size_t MiB = 1u << 20;
constexpr size_t WS_MODS = 0;
constexpr size_t WS_ROPE = 256 * 1024;
constexpr size_t WS_MPART = 1 * MiB;
constexpr size_t WS_BAR = 512 * 1024;
constexpr size_t WS_SSQ = 6 * MiB;
constexpr size_t WS_SSQ2 = 7 * MiB;
constexpr size_t WS_C5 = 7 * MiB + 128 * 1024;
constexpr size_t WS_C3 = 7 * MiB + 192 * 1024;
constexpr size_t WS_C3C = 7 * MiB + 224 * 1024;
constexpr size_t WS_SSQ1 = 7 * MiB + 256 * 1024;
constexpr size_t WS_WT1 = 8 * MiB, WS_WT2 = 52 * MiB, WS_WT3 = 74 * MiB, WS_WT4 = 98 * MiB, WS_WT5 = 106 * MiB, WS_WT6 = 150 * MiB;
constexpr size_t WS_H = 172 * MiB;
constexpr size_t WS_X1 = 237 * MiB;
constexpr size_t WS_G = 367 * MiB;
constexpr size_t WS_Q = 367 * MiB, WS_K = 399 * MiB, WS_VT = 432 * MiB, WS_BG = 465 * MiB, WS_Z = 497 * MiB;
constexpr size_t WS_A2 = 8 * MiB;
constexpr size_t WS_WT3U = 546 * MiB;
constexpr size_t WS_END = 554 * MiB;

__device__ __forceinline__ unsigned cvt_pk_bf16(float lo, float hi) { unsigned r; asm("v_cvt_pk_bf16_f32 %0, %1, %2" : "=v"(r) : "v"(lo), "v"(hi)); return r; }
__device__ __forceinline__ float bf2f(unsigned short b) { return __builtin_bit_cast(float, (unsigned)b << 16); }
__device__ __forceinline__ float wave_sum(float v) {
#pragma unroll
    for (int o = 1; o < 64; o <<= 1) v += __shfl_xor(v, o);
    return v;
}
__device__ __forceinline__ float silu_f(float a) { return a * __builtin_amdgcn_rcpf(1.0f + __builtin_amdgcn_exp2f(-a * LOG2E)); }

namespace pg8 {
constexpr int BM = 256, BK = 64, HALF = 128, HTB = HALF * BK * 2, STAGE_BYTES = 8 * HTB, NXCD = 8, WGM = 8;
__host__ __device__ __forceinline__ int lds_byte(int r, int c) { const int st = (r >> 4) * 2 + (c >> 5), rr = r & 15, cc = c & 31, ob = rr * 64 + cc * 2; return st * 1024 + (ob ^ (((ob >> 9) & 1) << 5)); }
__host__ __device__ __forceinline__ void stage_rc(int b, int& R, int& C) { const int st = b / 1024, sb = b % 1024, swz = sb ^ (((sb >> 9) & 1) << 5); R = (st >> 1) * 16 + swz / 64; C = (st & 1) * 32 + (swz % 64) / 2; }
__host__ __device__ __forceinline__ int perm32(int rho) { const int n = rho >> 4, i = rho & 15; return 8 * (i >> 2) + 4 * n + (i & 3); }

struct Unit { int pm, pn, kind; const char* pa; const char* pb; };

template <class Epi, class Sched>
__device__ __forceinline__ void gemm_phase(LAS unsigned char* lds, const int K, const Sched& S, const Epi& E) {
    const int tid = threadIdx.x, wid = __builtin_amdgcn_readfirstlane(tid >> 6), lane = tid & 63, wr = wid >> 2, wc = wid & 3, fr = lane & 15, fq = lane >> 4;
    const int nt = K / BK;
    unsigned voffA[2], voffB[2];
#pragma unroll
    for (int i = 0; i < 2; ++i) { int R, C; stage_rc(tid * 16 + i * 8192, R, C); const int Rb = (R & ~31) + perm32(R & 31);
        voffA[i] = (unsigned)(R * K + C) * 2u; voffB[i] = (unsigned)(Rb * K + C) * 2u; }
    const size_t kstep = (size_t)(BK * 2);
    const size_t hstep = (size_t)HALF * K * 2;
    const unsigned ldsw = (unsigned)wid * 1024u;
    const int aoff = lds_byte(wr * 64 + fr, fq * 8), boff = lds_byte(wc * 32 + fr, fq * 8);
#define PG8_SA(b, h) (((b) * 2 + (h)) * HTB)
#define PG8_SB(b, h) ((4 + (b) * 2 + (h)) * HTB)
#define PG8_STAGE(bufoff, gbase, voff) do { _Pragma("unroll") for (int _i = 0; _i < 2; ++_i) \
        __builtin_amdgcn_global_load_lds((const unsigned*)((const char*)(gbase) + (voff)[_i]), (LAS unsigned*)(lds + (bufoff) + ldsw + _i * 8192), 16, 0, 0); } while (0)
#define PG8_LDA(dst, b, h) do { _Pragma("unroll") for (int m = 0; m < 4; ++m) _Pragma("unroll") for (int k = 0; k < 2; ++k) dst[m][k] = *(const LAS bf16x8*)(lds + PG8_SA(b, h) + aoff + m * 2048 + k * 1024); } while (0)
#define PG8_LDB(dst, b, h) do { _Pragma("unroll") for (int n = 0; n < 2; ++n) _Pragma("unroll") for (int k = 0; k < 2; ++k) dst[n][k] = *(const LAS bf16x8*)(lds + PG8_SB(b, h) + boff + n * 2048 + k * 1024); } while (0)
#define PG8_MMA(ai, bj, At, Bt) do { __builtin_amdgcn_s_setprio(1); _Pragma("unroll") for (int m = 0; m < 4; ++m) _Pragma("unroll") for (int n = 0; n < 2; ++n) _Pragma("unroll") for (int k = 0; k < 2; ++k) \
        acc[ai][bj][m][n] = __builtin_amdgcn_mfma_f32_16x16x32_bf16(Bt[n][k], At[m][k], acc[ai][bj][m][n], 0, 0, 0); __builtin_amdgcn_s_setprio(0); } while (0)
#define PG8_WAIT_V(n) asm volatile("s_waitcnt vmcnt(" #n ")" ::: "memory")
#define PG8_WAIT_L(n) asm volatile("s_waitcnt lgkmcnt(" #n ")" ::: "memory")
#define PG8_BAR __builtin_amdgcn_s_barrier()
#define PG8_SCHED __builtin_amdgcn_sched_barrier(0)
    Unit cur, nxt; int ui = 0;
    if (!S.next(0, cur)) return;
    f32x4 acc[2][2][4][2];
#pragma unroll
    for (int a = 0; a < 2; ++a)
#pragma unroll
        for (int b = 0; b < 2; ++b)
#pragma unroll
            for (int m = 0; m < 4; ++m)
#pragma unroll
                for (int n = 0; n < 2; ++n) acc[a][b][m][n] = (f32x4){0.f, 0.f, 0.f, 0.f};
    bf16x8 At[4][2], B0[2][2], B1[2][2];
    const char* cA = cur.pa; const char* cB = cur.pb;
    PG8_STAGE(PG8_SB(0, 0), cB, voffB); PG8_STAGE(PG8_SB(0, 1), cB + hstep, voffB); PG8_STAGE(PG8_SA(0, 0), cA, voffA); PG8_STAGE(PG8_SA(0, 1), cA + hstep, voffA);
    if (wr == 1) PG8_BAR;
    PG8_WAIT_V(2); PG8_BAR;
    PG8_STAGE(PG8_SB(1, 0), cB + kstep, voffB); PG8_STAGE(PG8_SA(1, 0), cA + kstep, voffA); PG8_STAGE(PG8_SB(1, 1), cB + hstep + kstep, voffB);
    PG8_WAIT_V(6); PG8_BAR;
    for (;;) {
        const bool has_next = S.next(ui + 1, nxt);
        const char* nA = has_next ? nxt.pa : cA; const char* nB = has_next ? nxt.pb : cB;
        for (int t = 0; t < nt; t += 2) {
            const bool last = (t == nt - 2);
            if constexpr (Epi::MID) { if (t == (nt >> 1)) E.mid(acc, cur, wr, fr); }
            const char* a1 = cA + (size_t)(t + 1) * kstep;
            const char* a2 = last ? nA : cA + (size_t)(t + 2) * kstep; const char* b2 = last ? nB : cB + (size_t)(t + 2) * kstep;
            const char* a3 = a2 + kstep; const char* b3 = b2 + kstep;
            PG8_LDB(B0, 0, 0); PG8_LDB(B1, 0, 1); PG8_SCHED; PG8_LDA(At, 0, 0); PG8_STAGE(PG8_SA(1, 1), a1 + hstep, voffA);
            PG8_WAIT_V(8); PG8_WAIT_L(0); PG8_BAR; PG8_MMA(0, 0, At, B0); PG8_MMA(0, 1, At, B1); PG8_BAR; PG8_SCHED;
            PG8_LDA(At, 0, 1); PG8_STAGE(PG8_SB(0, 0), b2, voffB); PG8_STAGE(PG8_SB(0, 1), b2 + hstep, voffB); PG8_STAGE(PG8_SA(0, 0), a2, voffA);
            PG8_WAIT_V(8); PG8_WAIT_L(0); PG8_BAR; PG8_MMA(1, 0, At, B0); PG8_MMA(1, 1, At, B1); PG8_BAR; PG8_SCHED;
            PG8_LDB(B0, 1, 0); PG8_LDB(B1, 1, 1); PG8_SCHED; PG8_LDA(At, 1, 0); PG8_STAGE(PG8_SA(0, 1), a2 + hstep, voffA);
            PG8_WAIT_V(8); PG8_WAIT_L(0); PG8_BAR; PG8_MMA(0, 0, At, B0); PG8_MMA(0, 1, At, B1); PG8_BAR; PG8_SCHED;
            PG8_LDA(At, 1, 1); PG8_STAGE(PG8_SB(1, 0), b3, voffB); PG8_STAGE(PG8_SB(1, 1), b3 + hstep, voffB); PG8_STAGE(PG8_SA(1, 0), a3, voffA);
            PG8_WAIT_V(8); PG8_WAIT_L(0); PG8_BAR; PG8_MMA(1, 0, At, B0); PG8_MMA(1, 1, At, B1); PG8_BAR; PG8_SCHED;
        }
        if (wr == 0) PG8_BAR;
        E(acc, cur, wr, wc, fr, fq);
        if (!has_next) break;
#pragma unroll
        for (int a = 0; a < 2; ++a)
#pragma unroll
            for (int b = 0; b < 2; ++b)
#pragma unroll
                for (int m = 0; m < 4; ++m)
#pragma unroll
                    for (int n = 0; n < 2; ++n) acc[a][b][m][n] = (f32x4){0.f, 0.f, 0.f, 0.f};
        cur = nxt; cA = nA; cB = nB; ++ui;
        if (wr == 1) PG8_BAR;
    }
    PG8_WAIT_V(0);
    PG8_BAR;
#undef PG8_SA
#undef PG8_SB
#undef PG8_STAGE
#undef PG8_LDA
#undef PG8_LDB
#undef PG8_MMA
#undef PG8_WAIT_V
#undef PG8_WAIT_L
#undef PG8_BAR
#undef PG8_SCHED
}
}

enum { KQ = 0, KK = 1, KKCTX = 2, KBG = 3, KZ = 4, KVT = 5 };
struct GSched {
    const char* A; const char* B; int K, nM, nN, nX, mode, G, c;
    __device__ __forceinline__ bool next(int i, pg8::Unit& u) const {
        const int nwg = nM * nN; const long L = (long)i * G + c; if (L >= nwg + nX) return false;
        const size_t tstep = (size_t)256 * K * 2;
        if (L < nwg) {
            int wgid = (int)L; { const int q = nwg / pg8::NXCD, r = nwg % pg8::NXCD, xcd = wgid % pg8::NXCD, off = wgid / pg8::NXCD; wgid = (xcd < r ? xcd * (q + 1) : r * (q + 1) + (xcd - r) * q) + off; }
            const int nig = pg8::WGM * nN, gid = wgid / nig, fm = gid * pg8::WGM, gsz = (nM - fm) < pg8::WGM ? (nM - fm) : pg8::WGM;
            const int pm = fm + ((wgid % nig) % gsz), pi = (wgid % nig) / gsz;
            int pnB = pi, kind = 0;
            if (mode == 3) { pnB = pi < 8 ? pi : pi + 4; kind = pi < 4 ? KQ : pi < 8 ? KK : pi < 12 ? KBG : KZ; }
            u.pm = pm; u.pn = pnB; u.kind = kind; u.pa = A + (size_t)pm * tstep; u.pb = B + (size_t)pnB * tstep;
        } else {
            const int x = (int)(L - nwg);
            if (mode != 3) { u.pm = nM; u.pn = x; u.kind = 0; u.pa = A + (size_t)nM * tstep; u.pb = B + (size_t)x * tstep; }
            else { const int pmv = x >> 6, pnv = x & 63; u.pm = pmv; u.pn = pnv; u.kind = KVT; u.pa = B + (size_t)(8 + pmv) * tstep; u.pb = A + (size_t)pnv * tstep; }
        }
        return true;
    }
};

typedef f32x4 Acc[2][2][4][2];
template <bool ROWN> struct EpiSwiGLU {
    static constexpr bool MID = false;
    bf16_t* G; const float* ssq; const float* cvec;
    __device__ __forceinline__ void operator()(const Acc& acc, const pg8::Unit& u, int wr, int wc, int fr, int fq) const {
        const int row0 = u.pm * 256 + wr * 64 + fr, col0 = u.pn * 128 + wc * 32 + 8 * fq;
        f32x4 ca[2], cb[2];
        if (ROWN) {
#pragma unroll
            for (int n = 0; n < 2; ++n) { ca[n] = *(const f32x4*)(cvec + u.pn * 256 + wc * 32 + 8 * fq + 4 * n); cb[n] = *(const f32x4*)(cvec + u.pn * 256 + 128 + wc * 32 + 8 * fq + 4 * n); } }
#pragma unroll
        for (int ai = 0; ai < 2; ++ai)
#pragma unroll
            for (int m = 0; m < 4; ++m) {
                const int r = row0 + ai * 128 + m * 16;
                bf16_t* p = G + (size_t)r * FF + col0;
                f32x4 a0 = acc[ai][0][m][0], a1 = acc[ai][0][m][1], b0 = acc[ai][1][m][0], b1 = acc[ai][1][m][1];
                if (ROWN) { const float rinv = __builtin_amdgcn_rsqf(ssq[r] * (1.0f / DM) + EPS);
                    a0 = a0 * rinv + ca[0]; a1 = a1 * rinv + ca[1]; b0 = b0 * rinv + cb[0]; b1 = b1 * rinv + cb[1]; }
                u32x4 w;
                w.x = cvt_pk_bf16(silu_f(a0[0]) * b0[0], silu_f(a0[1]) * b0[1]); w.y = cvt_pk_bf16(silu_f(a0[2]) * b0[2], silu_f(a0[3]) * b0[3]);
                w.z = cvt_pk_bf16(silu_f(a1[0]) * b1[0], silu_f(a1[1]) * b1[1]); w.w = cvt_pk_bf16(silu_f(a1[2]) * b1[2], silu_f(a1[3]) * b1[3]);
                *(u32x4*)p = w;
            }
    }
};
template <bool EMIT, bool MIDH, bool BB, bool OB> struct EpiResid {
    const void* base; void* out; const float* gate; float s; float* ssq; const float* ssqA;
    static constexpr bool MID = MIDH;
    __device__ __forceinline__ void mid(Acc& acc, const pg8::Unit& u, int wr, int fr) const {
        const int row0 = u.pm * 256 + wr * 64 + fr;
#pragma unroll
        for (int ai = 0; ai < 2; ++ai)
#pragma unroll
            for (int m = 0; m < 4; ++m) { const float ra = __builtin_amdgcn_rsqf(ssqA[row0 + ai * 128 + m * 16] * (1.0f / DA) + EPS);
#pragma unroll
                for (int bj = 0; bj < 2; ++bj)
#pragma unroll
                    for (int n = 0; n < 2; ++n) acc[ai][bj][m][n] *= ra; }
    }
    __device__ __forceinline__ void operator()(const Acc& acc, const pg8::Unit& u, int wr, int wc, int fr, int fq) const {
        const int row0 = u.pm * 256 + wr * 64 + fr, col0 = u.pn * 256 + wc * 32 + 8 * fq;
        f32x4 gv[2][2];
#pragma unroll
        for (int bj = 0; bj < 2; ++bj)
#pragma unroll
            for (int n = 0; n < 2; ++n) gv[bj][n] = *(const f32x4*)(gate + col0 + bj * 128 + 4 * n) * s;
#pragma unroll
        for (int ai = 0; ai < 2; ++ai)
#pragma unroll
            for (int m = 0; m < 4; ++m) {
                const int r = row0 + ai * 128 + m * 16;
                const size_t off = (size_t)r * DM + col0;
                float ss = 0.f;
#pragma unroll
                for (int bj = 0; bj < 2; ++bj) {
                    f32x4 b0, b1;
                    if (BB) { const bf16x8 bv = *(const bf16x8*)((const bf16_t*)base + off + bj * 128);
                        b0 = (f32x4){bf2f((unsigned short)bv[0]), bf2f((unsigned short)bv[1]), bf2f((unsigned short)bv[2]), bf2f((unsigned short)bv[3])};
                        b1 = (f32x4){bf2f((unsigned short)bv[4]), bf2f((unsigned short)bv[5]), bf2f((unsigned short)bv[6]), bf2f((unsigned short)bv[7])}; }
                    else { b0 = __builtin_nontemporal_load((const f32x4*)((const float*)base + off + bj * 128)); b1 = __builtin_nontemporal_load((const f32x4*)((const float*)base + off + bj * 128 + 4)); }
                    const f32x4 o0 = b0 + gv[bj][0] * acc[ai][bj][m][0], o1 = b1 + gv[bj][1] * acc[ai][bj][m][1];
                    if (OB) { u32x4 w; w.x = cvt_pk_bf16(o0[0], o0[1]); w.y = cvt_pk_bf16(o0[2], o0[3]); w.z = cvt_pk_bf16(o1[0], o1[1]); w.w = cvt_pk_bf16(o1[2], o1[3]);
                        *(u32x4*)((bf16_t*)out + off + bj * 128) = w; }
                    else { *(f32x4*)((float*)out + off + bj * 128) = o0; *(f32x4*)((float*)out + off + bj * 128 + 4) = o1; }
                    if (EMIT) ss += (o0[0] * o0[0] + o0[1] * o0[1]) + (o0[2] * o0[2] + o0[3] * o0[3]) + (o1[0] * o1[0] + o1[1] * o1[1]) + (o1[2] * o1[2] + o1[3] * o1[3]);
                }
                if (EMIT) { ss += __shfl_xor(ss, 16); ss += __shfl_xor(ss, 32); if (fq == 0) unsafeAtomicAdd(ssq + r, ss); }
            }
    }
};
struct EpiInProj {
    static constexpr bool MID = false;
    bf16_t *Q, *Kb, *Vt, *BG, *Z; const float *qn, *kn, *rc, *rs; const float *ssq1, *c3;
    __device__ __forceinline__ float rinv_row(int r) const { return __builtin_amdgcn_rsqf(ssq1[r] * (1.0f / DM) + EPS); }
    __device__ __forceinline__ void qk(const Acc& acc, const f32x4 (&cv)[2][2], int row0, bf16_t* dst, int head, const float* gain, float oscale, int fq) const {
        f32x4 g[2][2];
#pragma unroll
        for (int bj = 0; bj < 2; ++bj)
#pragma unroll
            for (int n = 0; n < 2; ++n) g[bj][n] = *(const f32x4*)(gain + 32 * bj + 16 * n + 4 * fq);
#pragma unroll
        for (int ai = 0; ai < 2; ++ai)
#pragma unroll
            for (int m = 0; m < 4; ++m) {
                const int r = row0 + ai * 128 + m * 16;
                const float ri = rinv_row(r);
                f32x4 v[2][2];
                float ss = 0.f;
#pragma unroll
                for (int bj = 0; bj < 2; ++bj)
#pragma unroll
                    for (int n = 0; n < 2; ++n) { v[bj][n] = acc[ai][bj][m][n] * ri + cv[bj][n]; const f32x4 t = v[bj][n]; ss += (t[0] * t[0] + t[1] * t[1]) + (t[2] * t[2] + t[3] * t[3]); }
                ss += __shfl_xor(ss, 16); ss += __shfl_xor(ss, 32);
                const float rinv = __builtin_amdgcn_rsqf(ss * (1.0f / 64.0f) + EPS) * oscale;
                bf16_t* p = dst + (size_t)r * DA + head * 64 + 4 * fq;
#pragma unroll
                for (int bj = 0; bj < 2; ++bj) {
                    const f32x4 y0 = v[bj][0] * rinv * g[bj][0], y1 = v[bj][1] * rinv * g[bj][1];
                    const int pos = bj ? (r & 63) : (r >> 6);
                    const f32x4 C = *(const f32x4*)(rc + pos * 16 + 4 * fq), Sn = *(const f32x4*)(rs + pos * 16 + 4 * fq);
                    const f32x4 o1 = y0 * C - y1 * Sn, o2 = y0 * Sn + y1 * C;
                    u32x2 w1, w2; w1.x = cvt_pk_bf16(o1[0], o1[1]); w1.y = cvt_pk_bf16(o1[2], o1[3]); w2.x = cvt_pk_bf16(o2[0], o2[1]); w2.y = cvt_pk_bf16(o2[2], o2[3]);
                    *(u32x2*)(p + 32 * bj) = w1; *(u32x2*)(p + 32 * bj + 16) = w2;
                }
            }
    }
    __device__ __forceinline__ void operator()(const Acc& acc, const pg8::Unit& u, int wr, int wc, int fr, int fq) const {
        asm volatile("" : "+v"(fr), "+v"(fq));
        const int row0 = u.pm * 256 + wr * 64 + fr;
        if (u.kind == KVT) {
            f32x4 rv[2][2];
#pragma unroll
            for (int bj = 0; bj < 2; ++bj)
#pragma unroll
                for (int n = 0; n < 2; ++n) { const f32x4 q = *(const f32x4*)(ssq1 + u.pn * 256 + bj * 128 + wc * 32 + 8 * fq + 4 * n);
                    rv[bj][n] = (f32x4){__builtin_amdgcn_rsqf(q[0] * (1.0f / DM) + EPS), __builtin_amdgcn_rsqf(q[1] * (1.0f / DM) + EPS), __builtin_amdgcn_rsqf(q[2] * (1.0f / DM) + EPS), __builtin_amdgcn_rsqf(q[3] * (1.0f / DM) + EPS)}; }
            const int col0 = u.pn * 256 + wc * 32 + 8 * fq;
#pragma unroll
            for (int ai = 0; ai < 2; ++ai)
#pragma unroll
                for (int m = 0; m < 4; ++m) { const float cr = c3[2048 + row0 + ai * 128 + m * 16];
#pragma unroll
                    for (int bj = 0; bj < 2; ++bj) {
                        const f32x4 v0 = acc[ai][bj][m][0] * rv[bj][0] + cr, v1 = acc[ai][bj][m][1] * rv[bj][1] + cr;
                        u32x4 w; w.x = cvt_pk_bf16(v0[0], v0[1]); w.y = cvt_pk_bf16(v0[2], v0[3]); w.z = cvt_pk_bf16(v1[0], v1[1]); w.w = cvt_pk_bf16(v1[2], v1[3]);
                        *(u32x4*)(Vt + (size_t)(row0 + ai * 128 + m * 16) * MT + col0 + bj * 128) = w; } }
            return;
        }
        f32x4 cv[2][2];
#pragma unroll
        for (int bj = 0; bj < 2; ++bj)
#pragma unroll
            for (int n = 0; n < 2; ++n) cv[bj][n] = *(const f32x4*)(c3 + u.pn * 256 + bj * 128 + wc * 32 + 8 * fq + 4 * n);
        if (u.kind == KQ) { qk(acc, cv, row0, Q, 4 * u.pn + wc, qn, 0.125f * LOG2E, fq); }
        else if (u.kind == KK) { qk(acc, cv, row0, Kb, 4 * (u.pn - 4) + wc, kn, 1.0f, fq); }
        else if (u.kind == KZ) {
            const int col0 = (u.pn - 16) * 128 + wc * 32 + 8 * fq;
#pragma unroll
            for (int ai = 0; ai < 2; ++ai)
#pragma unroll
                for (int m = 0; m < 4; ++m) { const int r = row0 + ai * 128 + m * 16; const float ri = rinv_row(r);
                    const f32x4 z0 = (acc[ai][0][m][0] * ri + cv[0][0]) * (acc[ai][1][m][0] * ri + cv[1][0]), z1 = (acc[ai][0][m][1] * ri + cv[0][1]) * (acc[ai][1][m][1] * ri + cv[1][1]);
                    u32x4 w; w.x = cvt_pk_bf16(z0[0], z0[1]); w.y = cvt_pk_bf16(z0[2], z0[3]); w.z = cvt_pk_bf16(z1[0], z1[1]); w.w = cvt_pk_bf16(z1[2], z1[3]);
                    *(u32x4*)(Z + (size_t)r * DA + col0) = w; }
        } else {
            const int col0 = (u.pn - 12) * 256 + wc * 32 + 8 * fq;
#pragma unroll
            for (int ai = 0; ai < 2; ++ai)
#pragma unroll
                for (int m = 0; m < 4; ++m) { const int r = row0 + ai * 128 + m * 16; const float ri = rinv_row(r);
#pragma unroll
                    for (int bj = 0; bj < 2; ++bj) {
                        const f32x4 v0 = acc[ai][bj][m][0] * ri + cv[bj][0], v1 = acc[ai][bj][m][1] * ri + cv[bj][1];
                        u32x4 w; w.x = cvt_pk_bf16(v0[0], v0[1]); w.y = cvt_pk_bf16(v0[2], v0[3]); w.z = cvt_pk_bf16(v1[0], v1[1]); w.w = cvt_pk_bf16(v1[2], v1[3]);
                        *(u32x4*)(BG + (size_t)r * DA + col0 + bj * 128) = w; } }
        }
    }
};

__device__ __forceinline__ int colmap(int mode, int np) {
    if (mode == 1) { const int tile = np >> 8, w = np & 255; return (w >> 7) * FF + tile * 128 + (w & 127); }
    if (mode == 3) {
        if (np < 2048) { const int base = np & ~1023, rel = np & 1023, tile = rel >> 8, w = rel & 255;
            const int bj = w >> 7, wc = (w >> 5) & 3, fq = (w >> 3) & 3, n = (w >> 2) & 1, e = w & 3;
            return base + 64 * (4 * tile + wc) + 32 * bj + 16 * n + 4 * fq + e; }
        if (np < 4096) return np;
        const int rel = np - 4096, tile = rel >> 8, w = rel & 255; return ((w >> 7) ? 5120 : 4096) + tile * 128 + (w & 127);
    }
    return np;
}
__device__ __forceinline__ void transpose_item(const float* W, int K, int N, bf16_t* Wt, int mode, int item, int lane, const float* kgain = nullptr, int kglim = 0, const float* kscale = nullptr, const float* sh = nullptr, float* cacc = nullptr, bf16_t* Wu = nullptr, const float* kscale_u = nullptr, const float* sh_u = nullptr, float* cacc_u = nullptr, bool ntst = false) {
    const int nblk = N / 32, kb = item / nblk, nb = item % nblk;
    const int ns = lane & 7, kg = lane >> 3, np0 = nb * 32 + 4 * ns, c0 = colmap(mode, np0), k0 = kb * 64 + 8 * kg;
    f32x4 v[8];
#pragma unroll
    for (int j = 0; j < 8; ++j) v[j] = __builtin_nontemporal_load((const f32x4*)(W + (size_t)(k0 + j) * N + c0));
    if (sh != nullptr) {
        const f32x4 s0 = *(const f32x4*)(sh + k0), s1 = *(const f32x4*)(sh + k0 + 4);
        f32x4 p = v[0] * s0[0] + v[1] * s0[1] + v[2] * s0[2] + v[3] * s0[3] + v[4] * s1[0] + v[5] * s1[1] + v[6] * s1[2] + v[7] * s1[3];
#pragma unroll
        for (int e = 0; e < 4; ++e) { float q = p[e]; q += __shfl_xor(q, 8); q += __shfl_xor(q, 16); q += __shfl_xor(q, 32); p[e] = q; }
        if (kg == 0) {
#pragma unroll
            for (int e = 0; e < 4; ++e) unsafeAtomicAdd(cacc + np0 + e, p[e]); }
    }
    if (Wu != nullptr && np0 >= 1024 && np0 < 3072) {
        { const f32x4 s0 = *(const f32x4*)(sh_u + k0), s1 = *(const f32x4*)(sh_u + k0 + 4);
          f32x4 p = v[0] * s0[0] + v[1] * s0[1] + v[2] * s0[2] + v[3] * s0[3] + v[4] * s1[0] + v[5] * s1[1] + v[6] * s1[2] + v[7] * s1[3];
#pragma unroll
          for (int e = 0; e < 4; ++e) { float q = p[e]; q += __shfl_xor(q, 8); q += __shfl_xor(q, 16); q += __shfl_xor(q, 32); p[e] = q; }
          if (kg == 0) {
#pragma unroll
              for (int e = 0; e < 4; ++e) unsafeAtomicAdd(cacc_u + np0 - 1024 + e, p[e]); } }
        const f32x4 u0 = *(const f32x4*)(kgain + k0) * (*(const f32x4*)(kscale_u + k0) + 1.0f), u1 = *(const f32x4*)(kgain + k0 + 4) * (*(const f32x4*)(kscale_u + k0 + 4) + 1.0f);
#pragma unroll
        for (int e = 0; e < 4; ++e) { u32x4 w; w.x = cvt_pk_bf16(v[0][e] * u0[0], v[1][e] * u0[1]); w.y = cvt_pk_bf16(v[2][e] * u0[2], v[3][e] * u0[3]); w.z = cvt_pk_bf16(v[4][e] * u1[0], v[5][e] * u1[1]); w.w = cvt_pk_bf16(v[6][e] * u1[2], v[7][e] * u1[3]);
            *(u32x4*)(Wu + (size_t)(np0 - 1024 + e) * K + k0) = w; } }
    if (kgain != nullptr && k0 < kglim) {
        f32x4 g0 = *(const f32x4*)(kgain + k0), g1 = *(const f32x4*)(kgain + k0 + 4);
        if (kscale != nullptr) { g0 *= (*(const f32x4*)(kscale + k0) + 1.0f); g1 *= (*(const f32x4*)(kscale + k0 + 4) + 1.0f); }
        v[0] *= g0[0]; v[1] *= g0[1]; v[2] *= g0[2]; v[3] *= g0[3]; v[4] *= g1[0]; v[5] *= g1[1]; v[6] *= g1[2]; v[7] *= g1[3];
    }
#pragma unroll
    for (int e = 0; e < 4; ++e) { u32x4 w; w.x = cvt_pk_bf16(v[0][e], v[1][e]); w.y = cvt_pk_bf16(v[2][e], v[3][e]); w.z = cvt_pk_bf16(v[4][e], v[5][e]); w.w = cvt_pk_bf16(v[6][e], v[7][e]);
        if (ntst) __builtin_nontemporal_store(w, (u32x4*)(Wt + (size_t)(np0 + e) * K + k0));
        else *(u32x4*)(Wt + (size_t)(np0 + e) * K + k0) = w; }
}
__device__ __forceinline__ void ada_item(const float* wada, const float* cvec, const float* cctx, float* part, int item, int lane) {
    const int ks = item / 72, cc = item % 72;
    const float sx = silu_f(cvec[ks * 64 + lane]), sc = silu_f(cctx[ks * 64 + lane]);
    f32x4 ax = {0.f, 0.f, 0.f, 0.f}, ac = {0.f, 0.f, 0.f, 0.f};
    const float* wp = wada + (size_t)(ks * 64) * NMOD + cc * 256 + 4 * lane;
#pragma unroll 16
    for (int k = 0; k < 64; ++k) { const f32x4 w = __builtin_nontemporal_load((const f32x4*)(wp + (size_t)k * NMOD));
        const float a = __builtin_bit_cast(float, __builtin_amdgcn_readlane(__builtin_bit_cast(int, sx), k)), b = __builtin_bit_cast(float, __builtin_amdgcn_readlane(__builtin_bit_cast(int, sc), k));
        ax += w * a; ac += w * b; }
    *(f32x4*)(part + (size_t)(ks * 2 + 0) * NMOD + cc * 256 + 4 * lane) = ax;
    *(f32x4*)(part + (size_t)(ks * 2 + 1) * NMOD + cc * 256 + 4 * lane) = ac;
}
__device__ __forceinline__ void norm_rows(const float* src_x, const float* src_c, int nrows, bf16_t* H, const float* g, const float* mods, int ishift, int iscale, int gw, int ngw, int lane) {
    for (int m = gw; m < nrows; m += ngw) {
        const bool isc = m >= SEQ;
        const float* src = isc ? src_c + (size_t)(m - SEQ) * DM : src_x + (size_t)m * DM; const float* md = mods + (isc ? NMOD : 0);
        f32x4 v[8]; float ss = 0.f;
#pragma unroll
        for (int j = 0; j < 8; ++j) { v[j] = __builtin_nontemporal_load((const f32x4*)(src + 4 * lane + 256 * j)); ss += (v[j][0] * v[j][0] + v[j][1] * v[j][1]) + (v[j][2] * v[j][2] + v[j][3] * v[j][3]); }
        const float rinv = __builtin_amdgcn_rsqf(wave_sum(ss) * (1.0f / DM) + EPS);
#pragma unroll
        for (int j = 0; j < 8; ++j) { const int c = 4 * lane + 256 * j;
            const f32x4 gg = *(const f32x4*)(g + c), sc = *(const f32x4*)(md + iscale * DM + c), sh = *(const f32x4*)(md + ishift * DM + c);
            const f32x4 h = v[j] * rinv * gg * (sc + 1.0f) + sh;
            u32x2 w; w.x = cvt_pk_bf16(h[0], h[1]); w.y = cvt_pk_bf16(h[2], h[3]);
            *(u32x2*)(H + (size_t)m * DM + c) = w; }
    }
}

__device__ __forceinline__ void norm_rows_b16(const bf16_t* src, int nrows, bf16_t* H, const float* g, const float* mods, int ishift, int iscale, int gw, int ngw, int lane) {
    for (int m = gw; m < nrows; m += ngw) {
        const float* md = mods + (m >= SEQ ? NMOD : 0);
        bf16x8 v[4]; float ss = 0.f;
#pragma unroll
        for (int j = 0; j < 4; ++j) { v[j] = *(const bf16x8*)(src + (size_t)m * DM + 8 * lane + 512 * j);
#pragma unroll
            for (int e = 0; e < 8; ++e) { const float f = bf2f((unsigned short)v[j][e]); ss += f * f; } }
        const float rinv = __builtin_amdgcn_rsqf(wave_sum(ss) * (1.0f / DM) + EPS);
#pragma unroll
        for (int j = 0; j < 4; ++j) { const int c = 8 * lane + 512 * j; float h[8];
#pragma unroll
            for (int q = 0; q < 2; ++q) { const f32x4 gg = *(const f32x4*)(g + c + 4 * q), sc = *(const f32x4*)(md + iscale * DM + c + 4 * q), sh = *(const f32x4*)(md + ishift * DM + c + 4 * q);
#pragma unroll
                for (int e = 0; e < 4; ++e) h[4 * q + e] = bf2f((unsigned short)v[j][4 * q + e]) * rinv * gg[e] * (sc[e] + 1.0f) + sh[e]; }
            u32x4 w; w.x = cvt_pk_bf16(h[0], h[1]); w.y = cvt_pk_bf16(h[2], h[3]); w.z = cvt_pk_bf16(h[4], h[5]); w.w = cvt_pk_bf16(h[6], h[7]);
            *(u32x4*)(H + (size_t)m * DM + c) = w; }
    }
}

__device__ __forceinline__ void attn_unit(int u, const bf16_t* Q, const bf16_t* Kb, const bf16_t* Vt, const float* rpb, bf16_t* Y, float* ssq, LAS float* tab, const LAS unsigned char* ckv, int lane) {
    const int h = u >> 9, tile = u & 511, rp = tile >> 2, cg = tile & 3;
    const int ql = lane & 31, hi = lane >> 5;
    const int r0 = 2 * rp, qr = r0 + (ql >> 4), qc = 16 * cg + (ql & 15), qtok = qr * 64 + qc;
    for (int i = lane; i < 465; i += 64) tab[64 + i] = rpb[h * 465 + i] * LOG2E;
    bf16x8 qf[4];
#pragma unroll
    for (int c = 0; c < 4; ++c) qf[c] = *(const bf16x8*)(Q + (size_t)qtok * DA + h * 64 + 16 * c + 8 * hi);
    const int rs_q = min(max(qr - 4, 0), 248), cs_q = min(max(qc - 8, 0), 48);
    const int rs0 = min(max(r0 - 4, 0), 248), rs1 = min(max(r0 - 3, 0), 248);
    const int nblk = 8 + ((rs1 != rs0) ? 9 : 8);
    const int kc0 = min(max(16 * cg - 8, 0), 32);
    const unsigned vmask = (unsigned)((0xFFFFull << (cs_q - kc0 - 8 * hi + 8)) >> 8);
    const int kap = (ql & 19) | ((ql & 4) << 1) | ((ql & 8) >> 1);
    const bf16_t* kbase = Kb + (size_t)kap * DA + h * 64 + 8 * hi;
    const bf16_t* vbase = Vt + (size_t)(h * 64 + ql) * MT + 8 * hi;
    f32x16 o0, o1;
#pragma unroll
    for (int i = 0; i < 16; ++i) { o0[i] = 0.f; o1[i] = 0.f; }
    float mrun = -1e30f, lrun = 0.f;
    asm volatile("s_waitcnt lgkmcnt(0)" ::: "memory");
    auto block = [&](const bf16x8 (&kf)[4], const bf16x8 (&vf)[4], const bool local, const int kr) __attribute__((always_inline)) {
        f32x16 s;
#pragma unroll
        for (int i = 0; i < 16; ++i) s[i] = 0.f;
#pragma unroll
        for (int c = 0; c < 4; ++c) s = __builtin_amdgcn_mfma_f32_32x32x16_bf16(kf[c], qf[c], s, 0, 0, 0);
        if (local) {
            const unsigned vmr = ((kr >= rs_q) && (kr < rs_q + 8)) ? vmask : 0u;
            const int bi = 64 + (kr - qr + 7) * 31 + (kc0 + 8 * hi - qc + 15);
            float bs[16];
#pragma unroll
            for (int i = 0; i < 16; ++i) { const int j = 16 * (i >> 3) + 4 * ((i >> 2) & 1) + (i & 3); bs[i] = tab[bi + j]; }
            asm volatile("" ::: "memory");
#pragma unroll
            for (int i = 0; i < 16; ++i) { const int j = 16 * (i >> 3) + 4 * ((i >> 2) & 1) + (i & 3);
                const float t = s[i] + bs[i];
                s[i] = ((vmr >> j) & 1u) ? t : -1e30f; }
        }
        float bm = s[0];
#pragma unroll
        for (int i = 1; i < 16; ++i) bm = fmaxf(bm, s[i]);
        bm = fmaxf(bm, __shfl_xor(bm, 32));
        if (__builtin_amdgcn_ballot_w64(bm > mrun) != 0ull) {
            const float mnew = fmaxf(mrun, bm), alpha = __builtin_amdgcn_exp2f(mrun - mnew);
            mrun = mnew; lrun *= alpha;
#pragma unroll
            for (int i = 0; i < 16; ++i) { o0[i] *= alpha; o1[i] *= alpha; } }
        float ps = 0.f;
#pragma unroll
        for (int i = 0; i < 16; ++i) { s[i] = __builtin_amdgcn_exp2f(s[i] - mrun); ps += s[i]; }
        lrun += ps;
        u32x4 p0, p1;
        p0.x = cvt_pk_bf16(s[0], s[1]); p0.y = cvt_pk_bf16(s[2], s[3]); p0.z = cvt_pk_bf16(s[4], s[5]); p0.w = cvt_pk_bf16(s[6], s[7]);
        p1.x = cvt_pk_bf16(s[8], s[9]); p1.y = cvt_pk_bf16(s[10], s[11]); p1.z = cvt_pk_bf16(s[12], s[13]); p1.w = cvt_pk_bf16(s[14], s[15]);
        const bf16x8 pb0 = __builtin_bit_cast(bf16x8, p0), pb1 = __builtin_bit_cast(bf16x8, p1);
        o0 = __builtin_amdgcn_mfma_f32_32x32x16_bf16(vf[0], pb0, o0, 0, 0, 0);
        o0 = __builtin_amdgcn_mfma_f32_32x32x16_bf16(vf[1], pb1, o0, 0, 0, 0);
        o1 = __builtin_amdgcn_mfma_f32_32x32x16_bf16(vf[2], pb0, o1, 0, 0, 0);
        o1 = __builtin_amdgcn_mfma_f32_32x32x16_bf16(vf[3], pb1, o1, 0, 0, 0);
    };
    auto ldkv = [&](bf16x8 (&k)[4], bf16x8 (&v)[4], const int L) __attribute__((always_inline)) {
        const int tok0 = (rs0 + L) * 64 + kc0;
#pragma unroll
        for (int c = 0; c < 4; ++c) k[c] = *(const bf16x8*)(kbase + (size_t)tok0 * DA + 16 * c);
#pragma unroll
        for (int d = 0; d < 2; ++d)
#pragma unroll
            for (int t = 0; t < 2; ++t) v[d * 2 + t] = *(const bf16x8*)(vbase + (size_t)(32 * d) * MT + tok0 + 16 * t);
    };
    const int nloc = nblk - 8;
    bf16x8 kA[4], vA[4], kB[4], vB[4];
    ldkv(kA, vA, 0);
    for (int b = 0; b < 8; ++b) {
        bf16x8 kf[4], vf[4];
#pragma unroll
        for (int c = 0; c < 4; ++c) kf[c] = *(const LAS bf16x8*)(ckv + ((((b * 4 + c) * 2 + hi) * 32 + ql) << 4));
#pragma unroll
        for (int d = 0; d < 2; ++d)
#pragma unroll
            for (int t = 0; t < 2; ++t) vf[d * 2 + t] = *(const LAS bf16x8*)(ckv + 32768 + ((((((b * 2 + d) * 2 + t) * 2 + hi) * 32) + ql) << 4));
        block(kf, vf, false, 0);
    }
    for (int L = 0; L < nloc; L += 2) {
        ldkv(kB, vB, min(L + 1, nloc - 1));
        block(kA, vA, true, rs0 + L);
        if (L + 1 < nloc) { ldkv(kA, vA, min(L + 2, nloc - 1)); block(kB, vB, true, rs0 + L + 1); }
    }
    const float ltot = lrun + __shfl_xor(lrun, 32), inv = 1.0f / ltot;
    float sq = 0.f;
    bf16_t* yp = Y + (size_t)qtok * DM + h * 64 + 4 * hi;
#pragma unroll
    for (int a = 0; a < 4; ++a) {
        const float x0 = o0[4 * a] * inv, x1 = o0[4 * a + 1] * inv, x2 = o0[4 * a + 2] * inv, x3 = o0[4 * a + 3] * inv;
        const float y0 = o1[4 * a] * inv, y1 = o1[4 * a + 1] * inv, y2 = o1[4 * a + 2] * inv, y3 = o1[4 * a + 3] * inv;
        sq += (x0 * x0 + x1 * x1) + (x2 * x2 + x3 * x3) + (y0 * y0 + y1 * y1) + (y2 * y2 + y3 * y3);
        u32x2 w0, w1; w0.x = cvt_pk_bf16(x0, x1); w0.y = cvt_pk_bf16(x2, x3); w1.x = cvt_pk_bf16(y0, y1); w1.y = cvt_pk_bf16(y2, y3);
        *(u32x2*)(yp + 8 * a) = w0; *(u32x2*)(yp + 32 + 8 * a) = w1;
    }
    sq += __shfl_xor(sq, 32);
    if (hi == 0) unsafeAtomicAdd(ssq + qtok, sq);
}

__device__ __forceinline__ void conv_rows(const bf16_t* BG, const bf16_t* Z, const float* cw, const float* cb, const float* gc, bf16_t* Y, int gw, int ngw, int lane) {
    f32x4 w0[2][2], w1[2][2], w2[2][2], bb[2][2], gg[2][2];
#pragma unroll
    for (int hf = 0; hf < 2; ++hf)
#pragma unroll
        for (int q4 = 0; q4 < 2; ++q4) { const int ch = 512 * hf + 8 * lane + 4 * q4;
            w0[hf][q4] = *(const f32x4*)(cw + ch); w1[hf][q4] = *(const f32x4*)(cw + DA + ch); w2[hf][q4] = *(const f32x4*)(cw + 2 * DA + ch); bb[hf][q4] = *(const f32x4*)(cb + ch); gg[hf][q4] = *(const f32x4*)(gc + ch); }
    const bf16x8 zero8 = {0, 0, 0, 0, 0, 0, 0, 0};
    for (int t0 = gw * 8; t0 < SEQ; t0 += ngw * 8) {
        bf16x8 zp[2], zc[2], zn[2];
#pragma unroll
        for (int hf = 0; hf < 2; ++hf) { const int ch = 512 * hf + 8 * lane;
            zp[hf] = (t0 > 0) ? *(const bf16x8*)(Z + (size_t)(t0 - 1) * DA + ch) : zero8; zc[hf] = *(const bf16x8*)(Z + (size_t)t0 * DA + ch); }
#pragma unroll
        for (int i = 0; i < 8; ++i) { const int t = t0 + i;
            float val[16]; float ss = 0.f;
#pragma unroll
            for (int hf = 0; hf < 2; ++hf) { const int ch = 512 * hf + 8 * lane;
                zn[hf] = (t < SEQ - 1) ? *(const bf16x8*)(Z + (size_t)(t + 1) * DA + ch) : zero8;
                const bf16x8 bg = *(const bf16x8*)(BG + (size_t)t * DA + ch);
#pragma unroll
                for (int q4 = 0; q4 < 2; ++q4)
#pragma unroll
                    for (int e = 0; e < 4; ++e) { const int k = 4 * q4 + e;
                        const float y = bb[hf][q4][e] + w0[hf][q4][e] * bf2f((unsigned short)zp[hf][k]) + w1[hf][q4][e] * bf2f((unsigned short)zc[hf][k]) + w2[hf][q4][e] * bf2f((unsigned short)zn[hf][k]);
                        const float cv = bf2f((unsigned short)bg[k]) * y; val[8 * hf + k] = cv; ss += cv * cv; }
            }
            const float rinv = __builtin_amdgcn_rsqf(wave_sum(ss) * (1.0f / DA) + EPS);
#pragma unroll
            for (int hf = 0; hf < 2; ++hf) { const int ch = 512 * hf + 8 * lane;
                const f32x4 g0 = gg[hf][0], g1 = gg[hf][1];
                u32x4 w; w.x = cvt_pk_bf16(val[8 * hf + 0] * rinv * g0[0], val[8 * hf + 1] * rinv * g0[1]); w.y = cvt_pk_bf16(val[8 * hf + 2] * rinv * g0[2], val[8 * hf + 3] * rinv * g0[3]);
                w.z = cvt_pk_bf16(val[8 * hf + 4] * rinv * g1[0], val[8 * hf + 5] * rinv * g1[1]); w.w = cvt_pk_bf16(val[8 * hf + 6] * rinv * g1[2], val[8 * hf + 7] * rinv * g1[3]);
                *(u32x4*)(Y + (size_t)t * DM + DA + ch) = w;
                zp[hf] = zc[hf]; zc[hf] = zn[hf]; }
        }
    }
}
__device__ __forceinline__ void ynorm_rows(bf16_t* Y, const float* ssq, const float* ga, int gw, int ngw, int lane) {
    for (int t = gw; t < SEQ; t += ngw) {
        const float part = lane < NH ? ssq[lane * SEQ + t] : 0.f;
        const float rinv = __builtin_amdgcn_rsqf(wave_sum(part) * (1.0f / DA) + EPS);
#pragma unroll
        for (int hf = 0; hf < 2; ++hf) {
            const int ch = 512 * hf + 8 * lane;
            const bf16x8 a = *(const bf16x8*)(Y + (size_t)t * DM + ch);
            const f32x4 g0 = *(const f32x4*)(ga + ch), g1 = *(const f32x4*)(ga + ch + 4);
            u32x4 w; w.x = cvt_pk_bf16(bf2f((unsigned short)a[0]) * rinv * g0[0], bf2f((unsigned short)a[1]) * rinv * g0[1]); w.y = cvt_pk_bf16(bf2f((unsigned short)a[2]) * rinv * g0[2], bf2f((unsigned short)a[3]) * rinv * g0[3]);
            w.z = cvt_pk_bf16(bf2f((unsigned short)a[4]) * rinv * g1[0], bf2f((unsigned short)a[5]) * rinv * g1[1]); w.w = cvt_pk_bf16(bf2f((unsigned short)a[6]) * rinv * g1[2], bf2f((unsigned short)a[7]) * rinv * g1[3]);
            *(u32x4*)(Y + (size_t)t * DM + ch) = w;
        }
    }
}


template <class Fin>
__device__ __forceinline__ void wg_gemm64(const bf16_t* act, const bf16_t* w0, const bf16_t* w1, const int K, LAS unsigned char* lds, int wave, int lane, const Fin& fin) {
    const int ql = lane & 31, hi = lane >> 5;
    const int kw = K >> 3;
    unsigned voff[2];
    const int r16 = lane >> 2, g4 = lane & 3;
#pragma unroll
    for (int i = 0; i < 2; ++i) voff[i] = (unsigned)((16 * i + r16) * K + 8 * g4) * 2u;
    const char* gp0 = (const char*)(act + wave * kw); const char* gp1 = (const char*)(act + (size_t)32 * K + wave * kw); const char* gp2 = (const char*)(w0 + wave * kw); const char* gp3 = (const char*)(w1 + wave * kw);
    LAS unsigned char* wl = lds + wave * 16384;
    const int woff = r16 * 64 + ((g4 ^ ((r16 >> 1) & 3)) << 4);
    const int roff = ql * 64;
    f32x16 acc[2][2];
#pragma unroll
    for (int cb = 0; cb < 2; ++cb)
#pragma unroll
        for (int rb = 0; rb < 2; ++rb)
#pragma unroll
            for (int i = 0; i < 16; ++i) acc[cb][rb][i] = 0.f;
    bf16x8 st[4][2];
#pragma unroll
    for (int i = 0; i < 2; ++i) { st[0][i] = *(const bf16x8*)(gp0 + voff[i]); st[1][i] = *(const bf16x8*)(gp1 + voff[i]); st[2][i] = *(const bf16x8*)(gp2 + voff[i]); st[3][i] = *(const bf16x8*)(gp3 + voff[i]); }
    for (int k = 0; k < kw; k += 32) {
#pragma unroll
        for (int b4 = 0; b4 < 4; ++b4)
#pragma unroll
            for (int i = 0; i < 2; ++i) *(LAS bf16x8*)(wl + (b4 * 32 + 16 * i) * 64 + woff) = st[b4][i];
        asm volatile("" ::: "memory");
        if (k + 32 < kw) {
#pragma unroll
            for (int i = 0; i < 2; ++i) { const size_t ko = (size_t)(k + 32) * 2; st[0][i] = *(const bf16x8*)(gp0 + ko + voff[i]); st[1][i] = *(const bf16x8*)(gp1 + ko + voff[i]); st[2][i] = *(const bf16x8*)(gp2 + ko + voff[i]); st[3][i] = *(const bf16x8*)(gp3 + ko + voff[i]); }
        }
#pragma unroll
        for (int sub = 0; sub < 2; ++sub) {
            const int go = ((2 * sub + hi) ^ ((ql >> 1) & 3)) << 4;
            const bf16x8 a0 = *(const LAS bf16x8*)(wl + roff + go), a1 = *(const LAS bf16x8*)(wl + 2048 + roff + go), b0 = *(const LAS bf16x8*)(wl + 4096 + roff + go), b1 = *(const LAS bf16x8*)(wl + 6144 + roff + go);
            acc[0][0] = __builtin_amdgcn_mfma_f32_32x32x16_bf16(b0, a0, acc[0][0], 0, 0, 0);
            acc[0][1] = __builtin_amdgcn_mfma_f32_32x32x16_bf16(b0, a1, acc[0][1], 0, 0, 0);
            acc[1][0] = __builtin_amdgcn_mfma_f32_32x32x16_bf16(b1, a0, acc[1][0], 0, 0, 0);
            acc[1][1] = __builtin_amdgcn_mfma_f32_32x32x16_bf16(b1, a1, acc[1][1], 0, 0, 0);
        }
        asm volatile("" ::: "memory");
    }
#pragma unroll
    for (int cb = 0; cb < 2; ++cb)
#pragma unroll
        for (int rb = 0; rb < 2; ++rb)
#pragma unroll
            for (int ig = 0; ig < 4; ++ig) { const int row = 32 * rb + ql, g = 8 * cb + 2 * ig + hi;
                *(LAS f32x4*)(lds + (((wave * 64 + row) * 16 + (g ^ (row & 15))) << 4)) = (f32x4){acc[cb][rb][4 * ig], acc[cb][rb][4 * ig + 1], acc[cb][rb][4 * ig + 2], acc[cb][rb][4 * ig + 3]}; }
    __syncthreads();
    const int c = ql, hh = hi;
#pragma unroll
    for (int j = 0; j < 4; ++j) { const int r = wave * 8 + hh * 4 + j;
        float va = 0.f, vb = 0.f;
#pragma unroll
        for (int w = 0; w < 8; ++w) {
            va += *(const LAS float*)(lds + ((((w * 64 + r) * 16 + ((c >> 2) ^ (r & 15))) << 4) + ((c & 3) << 2)));
            vb += *(const LAS float*)(lds + ((((w * 64 + r) * 16 + ((8 + (c >> 2)) ^ (r & 15))) << 4) + ((c & 3) << 2))); }
        fin(r, c, va, vb); }
    __syncthreads();
}

#define XB_TMO      128
#define XB_XCNT(j)  (256  + 64 * (j))
#define XB_XSUB(j)  (1280 + 64 * (j))
#define XB_XGEN(j)  (2304 + 64 * (j))
#define XB_TOP      3328
#define XB_TOPGEN   3392
#define XCD_BAR_WORDS 3456
#define XB_SPIN_CAP (1u << 18)
__device__ __forceinline__ unsigned xb_ld(unsigned* p)              { return __hip_atomic_load(p, __ATOMIC_RELAXED, __HIP_MEMORY_SCOPE_AGENT); }
__device__ __forceinline__ unsigned xb_add(unsigned* p, unsigned v) { return __hip_atomic_fetch_add(p, v, __ATOMIC_RELAXED, __HIP_MEMORY_SCOPE_AGENT); }
__device__ __forceinline__ unsigned xb_xcc_id() { return (unsigned)__builtin_amdgcn_s_getreg((3 << 11) | 20) & 0xFu; }
#define XB_SPIN(cond, bar) do { unsigned _sp = 0; while (cond) { __builtin_amdgcn_s_sleep(1); \
    if ((++_sp & 255u) == 0u) { if (xb_ld(&(bar)[XB_TMO])) break; if (_sp > XB_SPIN_CAP) { atomicAdd(&(bar)[XB_TMO], 1u); break; } } } } while (0)
struct XcdBarrier { unsigned* bar; unsigned x; volatile LAS unsigned* st; };
__device__ __forceinline__ XcdBarrier xcd_barrier_post(unsigned* bar, volatile LAS unsigned* st) {
    XcdBarrier b; b.bar = bar; b.x = xb_xcc_id(); b.st = st;
    if (threadIdx.x == 0) (void)xb_add(&bar[XB_XCNT(b.x)], 1u);
    return b;
}
__device__ __forceinline__ void xcd_barrier_complete(unsigned* bar, unsigned x, unsigned& nloc, unsigned& nx) {
    const unsigned G = gridDim.x * gridDim.y * gridDim.z;
    unsigned sum, cnt, mine, sp = 0u;
    for (;;) {
        sum = 0u; cnt = 0u; mine = 0u;
#pragma unroll
        for (unsigned j = 0; j < 16; ++j) { const unsigned c = xb_ld(&bar[XB_XCNT(j)]); sum += c; cnt += (c > 0u) ? 1u : 0u; mine = (j == x) ? c : mine; }
        if (sum == G) break;
        __builtin_amdgcn_s_sleep(1);
        if ((++sp & 255u) == 0u) { if (xb_ld(&bar[XB_TMO])) break; if (sp > XB_SPIN_CAP) { atomicAdd(&bar[XB_TMO], 1u); break; } }
    }
    nloc = mine > 0u ? mine : 1u; nx = cnt > 0u ? cnt : 1u;
}
__device__ __forceinline__ void xcd_barrier(const XcdBarrier& b) {
    asm volatile("s_waitcnt vmcnt(0)" ::: "memory");
    __syncthreads();
    if (threadIdx.x == 0) {
        unsigned* bar = b.bar;
        __builtin_amdgcn_s_waitcnt(0);
        unsigned nloc = b.st[0], nx = b.st[1];
        if (nloc == 0u) { xcd_barrier_complete(bar, b.x, nloc, nx); b.st[0] = nloc; b.st[1] = nx; }
        const unsigned old = xb_add(&bar[XB_XSUB(b.x)], 1u);
        const unsigned gen = old / nloc;
        if (old + 1u == (gen + 1u) * nloc) {
            __builtin_amdgcn_fence(__ATOMIC_RELEASE, "agent");
            asm volatile("s_waitcnt vmcnt(0)" ::: "memory");
            const unsigned og = xb_add(&bar[XB_TOP], 1u);
            const unsigned tg = og / nx;
            if (og + 1u == (tg + 1u) * nx) xb_add(&bar[XB_TOPGEN], 1u);
            else XB_SPIN(xb_ld(&bar[XB_TOPGEN]) == tg, bar);
            __builtin_amdgcn_fence(__ATOMIC_ACQUIRE, "agent");
            xb_add(&bar[XB_XGEN(b.x)], 1u);
            asm volatile("s_waitcnt vmcnt(0)" ::: "memory");
        } else {
            XB_SPIN(xb_ld(&bar[XB_XGEN(b.x)]) == gen, bar);
            __builtin_amdgcn_fence(__ATOMIC_ACQUIRE, "agent");
            asm volatile("s_waitcnt vmcnt(0)" ::: "memory");
        }
    }
    __syncthreads();
}

constexpr int NPHASE = 13;
constexpr int LDS_BYTES = 147456;
struct Args { const float* in[22]; float* out; unsigned char* ws; int ph_lo, ph_hi; };

__global__ void __launch_bounds__(512, 2) fwd(Args a) {
    extern __shared__ __attribute__((aligned(16))) unsigned char lds_raw[];
    LAS unsigned char* lds = (LAS unsigned char*)lds_raw;
    const int tid = threadIdx.x, lane = tid & 63, wave = __builtin_amdgcn_readfirstlane(tid >> 6);
    const int G = gridDim.x, bx = blockIdx.x;
    const int vcu = (G % 8 == 0) ? (bx % 8) * (G / 8) + bx / 8 : bx;
    const int gw = vcu * 8 + wave, ngw = G * 8;
    unsigned char* ws = a.ws;
    const float *x = a.in[0], *cvec = a.in[1], *ctx = a.in[2], *cctx = a.in[3], *wada = a.in[4], *bada = a.in[5], *ff1n = a.in[6], *ff1wi = a.in[7], *ff1wo = a.in[8],
                *mixn = a.in[9], *win = a.in[10], *qn = a.in[11], *kn = a.in[12], *rpb = a.in[13], *convw = a.in[14], *convb = a.in[15], *ona = a.in[16], *onc = a.in[17],
                *wout = a.in[18], *ff2n = a.in[19], *ff2wi = a.in[20], *ff2wo = a.in[21];
    float* mods = (float*)(ws + WS_MODS); float* ropec = (float*)(ws + WS_ROPE); float* ropes = ropec + 256 * 16; float* mpart = (float*)(ws + WS_MPART); float* ssq = (float*)(ws + WS_SSQ);
    bf16_t *Wt1 = (bf16_t*)(ws + WS_WT1), *Wt2 = (bf16_t*)(ws + WS_WT2), *Wt3 = (bf16_t*)(ws + WS_WT3), *Wt4 = (bf16_t*)(ws + WS_WT4), *Wt5 = (bf16_t*)(ws + WS_WT5), *Wt6 = (bf16_t*)(ws + WS_WT6);
    bf16_t *H = (bf16_t*)(ws + WS_H), *Gb = (bf16_t*)(ws + WS_G), *Qb = (bf16_t*)(ws + WS_Q), *Kb = (bf16_t*)(ws + WS_K), *Vt = (bf16_t*)(ws + WS_VT), *BG = (bf16_t*)(ws + WS_BG), *Zb = (bf16_t*)(ws + WS_Z);
    bf16_t* X1b = (bf16_t*)(ws + WS_X1); float* ssq1 = (float*)(ws + WS_SSQ1); float* c3 = (float*)(ws + WS_C3); float* c3c = (float*)(ws + WS_C3C); bf16_t* Wt3u = (bf16_t*)(ws + WS_WT3U); float* ssq2 = (float*)(ws + WS_SSQ2); float* c5 = (float*)(ws + WS_C5);
    const int lo = a.ph_lo, hi = a.ph_hi;
    volatile LAS unsigned* MISC = (volatile LAS unsigned*)(lds + 131072 + 320);
    if (tid < 32) MISC[tid] = 0u;
    __syncthreads();
    unsigned* barw = (unsigned*)(ws + WS_BAR);
    XcdBarrier bar; bar.bar = barw; bar.x = 0; bar.st = MISC + 8;
    if (MK_N_LAUNCHES == 1) bar = xcd_barrier_post(barw, MISC + 8);
#define IN(k) (lo <= (k) && (k) < hi)
#define SEAM(k) do { if (IN(k) && IN((k) + 1)) xcd_barrier(bar); } while (0)

    TP_START(0);
    if (IN(0)) for (int rep = 0; rep < REP(0); ++rep) {
        constexpr int I_ADA = KSPLIT * 72, I_1 = (DM / 64) * (FF2 / 32), I_2 = (FF / 64) * (DM / 32);
        constexpr int NIT = I_ADA + I_1 + I_2;
        for (int it = gw; it < NIT; it += ngw) {
            int r = it;
            if (r < I_ADA) { ada_item(wada, cvec, cctx, mpart, r, lane); continue; } r -= I_ADA;
            if (r < I_1) { transpose_item(ff1wi, DM, FF2, Wt1, 1, r, lane); continue; } r -= I_1;
            transpose_item(ff1wo, FF, DM, Wt2, 0, r, lane);
        }
    }
    if (a.ph_lo < 0) __ockl_grid_sync();
    SEAM(0);
    TP_END(0);
    TP_START(1);
    if (IN(1)) for (int rep = 0; rep < REP(1); ++rep) {
        const int gt = bx * 512 + tid;
        if (gt < 2 * NMOD / 4) { const int v = gt / (NMOD / 4), j = (gt % (NMOD / 4)) * 4;
            f32x4 s = *(const f32x4*)(bada + j);
            for (int ks = 0; ks < KSPLIT; ++ks) s += *(const f32x4*)(mpart + (size_t)(ks * 2 + v) * NMOD + j);
            *(f32x4*)(mods + v * NMOD + j) = s; }
        else if (gt < 2 * NMOD / 4 + 4096) { const int idx = gt - 2 * NMOD / 4, pos = idx >> 4, i = idx & 15;
            const int i3 = i & 3; const float base4 = i3 == 0 ? 1.0f : i3 == 1 ? 0.5623413251903491f : i3 == 2 ? 0.31622776601683794f : 0.1778279410038923f;
            const int i2 = i >> 2; const float dec = i2 == 0 ? 1.0f : i2 == 1 ? 0.1f : i2 == 2 ? 0.01f : 0.001f;
            const float inv = base4 * dec;
            const float angf = (float)pos * inv;
            const double ang = (double)angf;
            const double r = ang - 6.283185307179586 * __builtin_rint(ang * 0.15915494309189535);
            const double r2 = r * r; double sn = r, cs = 1.0, ts = r, tc = 1.0;
#pragma unroll
            for (int k = 1; k <= 12; ++k) { tc = -tc * r2 / (double)((2 * k - 1) * (2 * k)); cs += tc; ts = -ts * r2 / (double)((2 * k) * (2 * k + 1)); sn += ts; }
            ropec[idx] = (float)cs; ropes[idx] = (float)sn; }
        else if (gt < 2 * NMOD / 4 + 4096 + SEQ / 4) { *(f32x4*)(ssq2 + 4 * (gt - (2 * NMOD / 4 + 4096))) = (f32x4){0.f, 0.f, 0.f, 0.f}; }
        else if (gt < 2 * NMOD / 4 + 4096 + 2 * (SEQ / 4)) { *(f32x4*)(ssq + 4 * (gt - (2 * NMOD / 4 + 4096 + SEQ / 4))) = (f32x4){0.f, 0.f, 0.f, 0.f}; }
        else if (gt >= 60000 && gt < 60000 + DM / 4) { *(f32x4*)(c3c + 4 * (gt - 60000)) = (f32x4){0.f, 0.f, 0.f, 0.f}; }
        else if (gt >= 40000 && gt < 40000 + MT / 4) { *(f32x4*)(ssq1 + 4 * (gt - 40000)) = (f32x4){0.f, 0.f, 0.f, 0.f}; }
        else if (gt >= 50000 && gt < 50000 + DIN / 4) { *(f32x4*)(c3 + 4 * (gt - 50000)) = (f32x4){0.f, 0.f, 0.f, 0.f}; }
        else if (gt < 2 * NMOD / 4 + 4096 + 2 * (SEQ / 4) + FF2 / 4) { *(f32x4*)(c5 + 4 * (gt - (2 * NMOD / 4 + 4096 + 2 * (SEQ / 4)))) = (f32x4){0.f, 0.f, 0.f, 0.f}; }
    }
    SEAM(1);
    TP_END(1);
    TP_START(2);
    if (IN(2)) { norm_rows(x, ctx, MT, H, ff1n, mods, 0, 1, gw, ngw, lane);
        for (int it = gw; it < (DM / 64) * (DIN / 32); it += ngw) transpose_item(win, DM, DIN, Wt3, 3, it, lane, mixn, DM, mods + 4 * DM, mods + 3 * DM, c3, Wt3u, mods + NMOD + 4 * DM, mods + NMOD + 3 * DM, c3c, true);
        { constexpr int J_1 = (DM / 64) * (FF2 / 32), J_2 = (FF / 64) * (DM / 32), J_4 = (DM / 64) * (DM / 32), NJ = J_4 + J_1 + J_2;
          for (int ti = gw; ti < NJ; ti += ngw) { int r = ti;
              if (r < J_4) transpose_item(wout, DM, DM, Wt4, 0, r, lane, ona, DA, nullptr, nullptr, nullptr, nullptr, nullptr, nullptr, nullptr, true);
              else if ((r -= J_4) < J_1) transpose_item(ff2wi, DM, FF2, Wt5, 1, r, lane, ff2n, DM, mods + 7 * DM, mods + 6 * DM, c5, nullptr, nullptr, nullptr, nullptr, true);
              else transpose_item(ff2wo, FF, DM, Wt6, 0, r - J_1, lane, nullptr, 0, nullptr, nullptr, nullptr, nullptr, nullptr, nullptr, nullptr, true); } } }
    SEAM(2);
    TP_END(2);
    TP_START(3);
    if (IN(3)) {
#define P3_CTX() for (int u = vcu; u < 4 * 176; u += G) { const int rb2 = u & 3, jb = u >> 2, tile = jb >> 2, wq = (jb & 3) * 32; \
            const bf16_t* w0 = Wt1 + (size_t)(256 * tile + wq) * DM; \
            bf16_t* gp = Gb + (size_t)(SEQ + 64 * rb2) * FF + 32 * jb; \
            wg_gemm64(H + (size_t)(SEQ + 64 * rb2) * DM, w0, w0 + (size_t)128 * DM, DM, lds, wave, lane, \
                      [&](int r, int c, float va, float vb) { gp[(size_t)r * FF + c] = (bf16_t)(cvt_pk_bf16(silu_f(va) * vb, 0.f) & 0xffffu); }); }
        if (bx & 1) { P3_CTX() }
        { GSched S{(const char*)H, (const char*)Wt1, DM, 64, 44, 0, 0, G, bx}; EpiSwiGLU<false> E{Gb, nullptr, nullptr}; pg8::gemm_phase(lds, DM, S, E); }
        if (!(bx & 1)) { P3_CTX() }
#undef P3_CTX
    }
    SEAM(3);
    TP_END(3);
    TP_START(4);
    if (IN(4)) {
        for (int u = vcu; u < 4 * 32; u += G) { const int rb2 = u & 3, cb2 = u >> 2;
            const bf16_t* w0 = Wt2 + (size_t)(64 * cb2) * FF;
            const float* bp = ctx + (size_t)(64 * rb2) * DM + 64 * cb2; bf16_t* op = X1b + (size_t)(SEQ + 64 * rb2) * DM + 64 * cb2; const float* gp = mods + NMOD + 2 * DM + 64 * cb2;
            wg_gemm64(Gb + (size_t)(SEQ + 64 * rb2) * FF, w0, w0 + (size_t)32 * FF, FF, lds, wave, lane,
                      [&](int r, int c, float va, float vb) { const float xa = bp[(size_t)r * DM + c] + 0.5f * gp[c] * va, xb = bp[(size_t)r * DM + c + 32] + 0.5f * gp[c + 32] * vb;
                          op[(size_t)r * DM + c] = (bf16_t)(cvt_pk_bf16(xa, 0.f) & 0xffffu); op[(size_t)r * DM + c + 32] = (bf16_t)(cvt_pk_bf16(xb, 0.f) & 0xffffu);
                          float ss = xa * xa + xb * xb;
#pragma unroll
                          for (int o = 1; o < 32; o <<= 1) ss += __shfl_xor(ss, o);
                          if (c == 0) unsafeAtomicAdd(ssq1 + SEQ + 64 * rb2 + r, ss); }); }
        GSched S{(const char*)Gb, (const char*)Wt2, FF, 64, 8, 0, 0, G, bx}; EpiResid<true, false, false, true> E{x, X1b, mods + 2 * DM, 0.5f, ssq1, nullptr}; pg8::gemm_phase(lds, FF, S, E); }
    SEAM(4);
    TP_END(4);
    TP_START(6);
    if (IN(6)) {
        for (int u = vcu; u < 128; u += G) {
            if (u < 64) { const int rb2 = u & 3, hd = u >> 2;
                const bf16_t* w0 = Wt3u + (size_t)(256 * (hd >> 2) + 32 * (hd & 3)) * DM;
                bf16_t* kp = Kb + (size_t)(SEQ + 64 * rb2) * DA + 64 * hd;
                const int nb = 256 * (hd >> 2) + 32 * (hd & 3);
                wg_gemm64(X1b + (size_t)(SEQ + 64 * rb2) * DM, w0, w0 + (size_t)128 * DM, DM, lds, wave, lane,
                          [&](int r, int c, float va, float vb) { const float ri = __builtin_amdgcn_rsqf(ssq1[SEQ + 64 * rb2 + r] * (1.0f / DM) + EPS);
                              va = va * ri + c3c[nb + c]; vb = vb * ri + c3c[nb + 128 + c];
                              float ss = va * va + vb * vb;
#pragma unroll
                              for (int o = 1; o < 32; o <<= 1) ss += __shfl_xor(ss, o);
                              const float rinv = __builtin_amdgcn_rsqf(ss * (1.0f / 64.0f) + EPS); const int d = 16 * ((c >> 2) & 1) + 4 * (c >> 3) + (c & 3);
                              kp[(size_t)r * DA + d] = (bf16_t)(cvt_pk_bf16(va * rinv * kn[d], 0.f) & 0xffffu); kp[(size_t)r * DA + d + 32] = (bf16_t)(cvt_pk_bf16(vb * rinv * kn[d + 32], 0.f) & 0xffffu); }); }
            else { const int v = u - 64, hb = v >> 2, tb = v & 3;
                const bf16_t* w0 = X1b + (size_t)(SEQ + 64 * tb) * DM;
                bf16_t* vp = Vt + (size_t)(64 * hb) * MT + SEQ + 64 * tb;
                wg_gemm64(Wt3u + (size_t)(1024 + 64 * hb) * DM, w0, w0 + (size_t)32 * DM, DM, lds, wave, lane,
                          [&](int r, int c, float va, float vb) { const float cr = c3c[1024 + 64 * hb + r];
                              va = va * __builtin_amdgcn_rsqf(ssq1[SEQ + 64 * tb + c] * (1.0f / DM) + EPS) + cr; vb = vb * __builtin_amdgcn_rsqf(ssq1[SEQ + 64 * tb + c + 32] * (1.0f / DM) + EPS) + cr;
                              vp[(size_t)r * MT + c] = (bf16_t)(cvt_pk_bf16(va, 0.f) & 0xffffu); vp[(size_t)r * MT + c + 32] = (bf16_t)(cvt_pk_bf16(vb, 0.f) & 0xffffu); }); }
        }
        GSched S{(const char*)X1b, (const char*)Wt3, DM, 64, 20, 4 * 64, 3, G, bx}; EpiInProj E{Qb, Kb, Vt, BG, Zb, qn, kn, ropec, ropes, ssq1, c3}; pg8::gemm_phase(lds, DM, S, E); }
    SEAM(6);
    TP_END(6);
    TP_START(7);
    if (IN(7)) for (int rep = 0; rep < REP(7); ++rep) {
        LAS float* tab = (LAS float*)(lds + wave * 4096);
        constexpr int J_1 = (DM / 64) * (FF2 / 32), J_2 = (FF / 64) * (DM / 32), J_4 = (DM / 64) * (DM / 32), NJ = J_4 + J_1 + J_2;
        int ti = 1 << 30;
#define P7_ITEM() do { int r = ti; if (r < J_4) transpose_item(wout, DM, DM, Wt4, 0, r, lane, ona, DA); else if ((r -= J_4) < J_1) transpose_item(ff2wi, DM, FF2, Wt5, 1, r, lane, ff2n, DM, mods + 7 * DM, mods + 6 * DM, c5); else transpose_item(ff2wo, FF, DM, Wt6, 0, r - J_1, lane); ti += ngw; } while (0)
        const int upw = (NH * 512) / ngw;
        if (upw * ngw == NH * 512 && (8 * upw) <= 512 && 512 % (8 * upw) == 0) {
            const int hcu = (vcu * 8 * upw) >> 9;
            LAS unsigned char* ckv = lds + 32768;
            for (int j = 0; j < 4; ++j) { const int gi = tid + 512 * j;
                { const int key = gi >> 3, cg = gi & 7, kk = key & 31, m = (kk & 19) | ((kk & 4) << 1) | ((kk & 8) >> 1);
                  *(LAS bf16x8*)(ckv + (((((key >> 5) * 4 + (cg >> 1)) * 2 + (cg & 1)) * 32 + m) << 4)) = *(const bf16x8*)(Kb + (size_t)(SEQ + key) * DA + hcu * 64 + 8 * cg); }
                { const int d = gi >> 5, tg = gi & 31;
                  *(LAS bf16x8*)(ckv + 32768 + (((((((tg >> 2) * 2 + (d >> 5)) * 2 + ((tg >> 1) & 1)) * 2 + (tg & 1)) * 32) + (d & 31)) << 4)) = *(const bf16x8*)(Vt + (size_t)(hcu * 64 + d) * MT + SEQ + 8 * tg); } }
            __syncthreads();
            for (int i = 0; i < upw; ++i) { attn_unit(gw * upw + i, Qb, Kb, Vt, rpb, H, ssq, tab, ckv, lane);
                for (int q = 0; q < 3 && ti < NJ; ++q) P7_ITEM(); }
            __syncthreads();
        }
        while (ti < NJ) P7_ITEM();
#undef P7_ITEM
        conv_rows(BG, Zb, convw, convb, onc, H, gw, ngw, lane);
    }
    SEAM(7);
    TP_END(7);
    TP_START(9);
    if (IN(9)) for (int rep = 0; rep < REP(9); ++rep) { GSched S{(const char*)H, (const char*)Wt4, DM, 64, 8, 0, 0, G, bx}; EpiResid<true, true, true, true> E{X1b, X1b, mods + 5 * DM, 1.0f, ssq2, ssq}; pg8::gemm_phase(lds, DM, S, E); }
    SEAM(9);
    TP_END(9);
    TP_START(10);
    if (IN(10)) { }
    TP_END(10);
    TP_START(11);
    if (IN(11)) for (int rep = 0; rep < REP(11); ++rep) { GSched S{(const char*)X1b, (const char*)Wt5, DM, 64, 44, 0, 0, G, bx}; EpiSwiGLU<true> E{Gb, ssq2, c5}; pg8::gemm_phase(lds, DM, S, E); }
    SEAM(11);
    TP_END(11);
    TP_START(12);
    if (IN(12)) for (int rep = 0; rep < REP(12); ++rep) { GSched S{(const char*)Gb, (const char*)Wt6, FF, 64, 8, 0, 0, G, bx}; EpiResid<false, false, true, false> E{X1b, a.out, mods + 8 * DM, 0.5f, nullptr, nullptr}; pg8::gemm_phase(lds, FF, S, E); }
    TP_END(12);
#ifdef TPROBE_LO
    if (bx == 0 && tid == 0) { const unsigned long long t0_ = ((unsigned long long)MISC[17] << 32) | MISC[16], t1_ = ((unsigned long long)MISC[19] << 32) | MISC[18];
        const unsigned long long d_ = (t1_ - t0_) * TPROBE_MUL, s_ = __builtin_amdgcn_s_memrealtime();
        while (__builtin_amdgcn_s_memrealtime() - s_ < d_) __builtin_amdgcn_s_sleep(8); }
#endif
#undef IN
#undef SEAM
}

extern "C" void kernel_launch(void* const* d_in, const int* in_sizes, int n_in, void* d_out, int out_size, void* d_ws, size_t ws_size, hipStream_t stream) {
    static int grid = 0;
    if (grid == 0) {
        if (n_in != 22 || out_size != SEQ * DM || ws_size < WS_END) { fprintf(stderr, "kernel_launch: unexpected shapes (n_in %d out %d ws %zu)\n", n_in, out_size, ws_size); grid = -1; return; }
        int dev = 0, cus = 0, per_cu = 0;
        if (hipGetDevice(&dev) != hipSuccess || hipDeviceGetAttribute(&cus, hipDeviceAttributeMultiprocessorCount, dev) != hipSuccess) { grid = -1; return; }
        if (hipFuncSetAttribute((const void*)fwd, hipFuncAttributeMaxDynamicSharedMemorySize, LDS_BYTES) != hipSuccess) { fprintf(stderr, "kernel_launch: hipFuncSetAttribute failed\n"); grid = -1; return; }
        if (hipOccupancyMaxActiveBlocksPerMultiprocessor(&per_cu, (const void*)fwd, 512, LDS_BYTES) != hipSuccess || per_cu < 1) { fprintf(stderr, "kernel_launch: occupancy query says %d\n", per_cu); per_cu = 1; }
        (void)hipGetLastError();
        grid = cus;
    }
    if (grid < 0) return;
    Args a{};
    for (int i = 0; i < 22; ++i) a.in[i] = (const float*)d_in[i];
    a.out = (float*)d_out; a.ws = (unsigned char*)d_ws;
    if (MK_N_LAUNCHES == 1) {
        a.ph_lo = 0; a.ph_hi = NPHASE;
        if (hipMemsetAsync((char*)d_ws + WS_BAR, 0, XCD_BAR_WORDS * 4, stream) != hipSuccess) { fprintf(stderr, "kernel_launch: hipMemsetAsync failed\n"); return; }
        void* args[] = {&a};
        hipError_t e = hipLaunchCooperativeKernel((const void*)fwd, dim3(grid), dim3(512), args, LDS_BYTES, stream);
        if (e != hipSuccess) fprintf(stderr, "cooperative launch failed: %s (grid %d)\n", hipGetErrorString(e), grid);
    } else {
        for (int p = 0; p < NPHASE; ++p) { a.ph_lo = p; a.ph_hi = p + 1; hipLaunchKernelGGL(fwd, dim3(grid), dim3(512), LDS_BYTES, stream, a); }
    }
}
```
